# Optimizing an MI355X kernel written in HIP

```python
import jax, jax.numpy as jnp
from jax import lax
import numpy as np

D_MODEL = 2048
BATCH = 2
SEQ = 16384
DEPTH = 2

CHUNK = 64
EPS = 1e-6
NEG_INF = -1e30

A_HEADS = 6
A_DK = 128
A_DV = 128
A_QF = A_HEADS * A_DK
A_WIDTH = A_HEADS * A_DV

B_HEADS = 5
B_DH = 128
B_WIDTH = B_HEADS * B_DH
B_PREV_CHUNKS = 8
B_BAND = B_PREV_CHUNKS + 1
REL_CLIP = 128

C_HEADS = 5
C_DK = 64
C_DV = 128
C_QK = C_HEADS * C_DK
C_WIDTH = C_HEADS * C_DV
ROPE_BASE = 10000.0

D_MIX = A_WIDTH + B_WIDTH + C_WIDTH
SPLIT_SIZES = (A_QF, A_QF, A_WIDTH, A_WIDTH,
               B_WIDTH, B_WIDTH, B_WIDTH, B_WIDTH,
               C_QK, C_QK, C_WIDTH, C_WIDTH)
D_IN = 2 * A_QF + 2 * A_WIDTH + 4 * B_WIDTH + 2 * C_QK + 2 * C_WIDTH

kernel_name = "hybrid_hgrn2_bandattn_retention"


def rmsnorm(x, gain):
    x32 = x.astype(jnp.float32)
    y = x32 * lax.rsqrt(jnp.mean(x32 * x32, axis=-1, keepdims=True) + EPS)
    return (y * gain.astype(jnp.float32)).astype(x.dtype)


def split_columns(t):
    parts, start = [], 0
    for size in SPLIT_SIZES:
        parts.append(t[..., start:start + size])
        start += size
    return parts


def hgrn2_group(q, f_logit, i, lb, gain):
    f32 = jnp.float32
    bsz, s, _ = q.shape
    n = s // CHUNK
    lb = lb.astype(f32)
    z = f_logit.astype(f32)
    log_f = jnp.logaddexp(jnp.log(lb), jnp.log1p(-lb) + jax.nn.log_sigmoid(z))
    k = (1.0 - lb) * jax.nn.sigmoid(-z)
    q = jax.nn.silu(q.astype(f32)) * (A_DK ** -0.5)

    def to_chunks(t, d):
        return t.reshape(bsz, n, CHUNK, A_HEADS, d).transpose(1, 0, 3, 2, 4)

    qc, kc, gc = to_chunks(q, A_DK), to_chunks(k, A_DK), to_chunks(log_f, A_DK)
    vc = to_chunks(i.astype(f32), A_DV)
    causal = jnp.tril(jnp.ones((CHUNK, CHUNK), dtype=bool))

    def step(state, inp):
        qn, kn, vn, gn = inp
        b = jnp.cumsum(gn, axis=2)
        b_last = b[:, :, -1:, :]
        o_inter = jnp.einsum('bhtk,bhkv->bhtv', qn * jnp.exp(b), state)
        diff = b[:, :, :, None, :] - b[:, :, None, :, :]
        decay = jnp.exp(jnp.where(causal[:, :, None], diff, -jnp.inf))
        scores = jnp.einsum('bhtsk,bhsk->bhts', qn[:, :, :, None, :] * decay, kn)
        o = o_inter + jnp.einsum('bhts,bhsv->bhtv', scores, vn)
        new_state = (jnp.exp(b_last[:, :, 0, :])[..., None] * state
                     + jnp.einsum('bhsk,bhsv->bhkv', kn * jnp.exp(b_last - b), vn))
        return new_state, o

    s0 = jnp.zeros((bsz, A_HEADS, A_DK, A_DV), f32)
    _, o = lax.scan(step, s0, (qc, kc, vc, gc))
    o = o * lax.rsqrt(jnp.mean(o * o, axis=-1, keepdims=True) + EPS) * gain.astype(f32)
    return o.transpose(1, 0, 3, 2, 4).reshape(bsz, s, A_WIDTH)


def band_attention_group(q, k, v, rel_bias):
    f32 = jnp.float32
    bsz, s, _ = q.shape
    n = s // CHUNK

    def to_chunks(t):
        return t.reshape(bsz, n, CHUNK, B_HEADS, B_DH).transpose(0, 3, 1, 2, 4)

    qc, kc, vc = to_chunks(q), to_chunks(k), to_chunks(v)
    pad = ((0, 0), (0, 0), (B_PREV_CHUNKS, 0), (0, 0), (0, 0))
    band_idx = jnp.arange(n)[:, None] + jnp.arange(B_BAND)[None, :]
    k_band = jnp.pad(kc, pad)[:, :, band_idx].reshape(bsz, B_HEADS, n, B_BAND * CHUNK, B_DH)
    v_band = jnp.pad(vc, pad)[:, :, band_idx].reshape(bsz, B_HEADS, n, B_BAND * CHUNK, B_DH)

    q_pos = jnp.arange(CHUNK)
    k_pos = jnp.arange(B_BAND * CHUNK) - B_PREV_CHUNKS * CHUNK
    rel = q_pos[:, None] - k_pos[None, :]
    bias = rel_bias[:, jnp.clip(rel, -REL_CLIP, REL_CLIP) + REL_CLIP].astype(f32)
    valid = (jnp.arange(n)[:, None] + jnp.arange(B_BAND * CHUNK)[None, :] // CHUNK) >= B_PREV_CHUNKS

    scores = jnp.einsum('bhnqd,bhnkd->bhnqk', qc, k_band, preferred_element_type=f32)
    scores = scores * (B_DH ** -0.5) + bias[None, :, None]
    scores = jnp.where(valid[None, None, :, None, :], scores, NEG_INF)
    p = jax.nn.softmax(scores, axis=-1)
    o = jnp.einsum('bhnqk,bhnkd->bhnqd', p.astype(v_band.dtype), v_band, preferred_element_type=f32)
    return o.transpose(0, 2, 3, 1, 4).reshape(bsz, s, B_WIDTH)


def apply_rotary(t, cos, sin):
    t1, t2 = t[..., :C_DK // 2], t[..., C_DK // 2:]
    c, s = cos[None, :, None, :], sin[None, :, None, :]
    return jnp.concatenate([t1 * c - t2 * s, t1 * s + t2 * c], axis=-1)


def retention_group(q, k, v, cos, sin):
    f32 = jnp.float32
    bsz, s, _ = q.shape
    n = s // CHUNK
    q = apply_rotary(q.astype(f32).reshape(bsz, s, C_HEADS, C_DK), cos, sin)
    k = apply_rotary(k.astype(f32).reshape(bsz, s, C_HEADS, C_DK), cos, sin) * (C_DK ** -0.5)

    def to_chunks(t, d):
        return t.reshape(bsz, n, CHUNK, C_HEADS, d).transpose(0, 3, 1, 2, 4)

    qc, kc = to_chunks(q, C_DK), to_chunks(k, C_DK)
    vc = to_chunks(v.astype(f32).reshape(bsz, s, C_HEADS, C_DV), C_DV)

    log_gamma = jnp.log1p(-jnp.exp2(-5.0 - jnp.arange(C_HEADS, dtype=f32)))
    pos = jnp.arange(CHUNK, dtype=f32)
    rel = pos[:, None] - pos[None, :]
    decay_mask = jnp.where(rel >= 0, jnp.exp(log_gamma[:, None, None] * jnp.maximum(rel, 0.0)), 0.0)

    scores = jnp.einsum('bhnik,bhnjk->bhnij', qc, kc) * decay_mask[None, :, None]
    o_intra = jnp.einsum('bhnij,bhnjv->bhniv', scores, vc)

    k_dec = kc * jnp.exp(log_gamma[:, None] * (CHUNK - 1 - pos)[None, :])[None, :, None, :, None]
    d_state = jnp.einsum('bhnjk,bhnjv->bhnkv', k_dec, vc)
    chunk_decay = jnp.exp(log_gamma * CHUNK)[None, :, None, None]

    def step(state, ds):
        return chunk_decay * state + ds, state

    s0 = jnp.zeros((bsz, C_HEADS, C_DK, C_DV), f32)
    _, prev_state = lax.scan(step, s0, d_state.transpose(2, 0, 1, 3, 4))
    prev_state = prev_state.transpose(1, 2, 0, 3, 4)
    q_dec = qc * jnp.exp(log_gamma[:, None] * (pos + 1.0)[None, :])[None, :, None, :, None]
    o = o_intra + jnp.einsum('bhnik,bhnkv->bhniv', q_dec, prev_state)
    o = o * lax.rsqrt(jnp.mean(o * o, axis=-1, keepdims=True) + EPS)
    return o.transpose(0, 2, 3, 1, 4).reshape(bsz, s, C_WIDTH)


def hybrid_layer(x, w_in, norm_gain, lb, hgrn_gain, rel_bias, w_out, cos, sin):
    h = rmsnorm(x, norm_gain)
    proj = jnp.einsum('bsd,de->bse', h, w_in)
    aq, af, ai, ag, bq, bk, bv, bg, cq, ck, cv, cg = split_columns(proj)
    ya = hgrn2_group(aq, af, ai, lb, hgrn_gain).astype(x.dtype) * jax.nn.silu(ag)
    yb = band_attention_group(bq, bk, bv, rel_bias).astype(x.dtype) * jax.nn.silu(bg)
    yc = retention_group(cq, ck, cv, cos, sin).astype(x.dtype) * jax.nn.silu(cg)
    y = jnp.concatenate([ya, yb, yc], axis=-1)
    return x + jnp.einsum('bse,ed->bsd', y, w_out)


def setup_inputs(seed: int = 0) -> dict:
    key = jax.random.key(seed)
    ks = jax.random.split(key, 8)
    x = jax.random.normal(ks[0], (BATCH, SEQ, D_MODEL), jnp.float32)
    w_in = jax.random.normal(ks[1], (DEPTH, D_MODEL, D_IN), jnp.float32) * D_MODEL ** -0.5
    norm_gain = 1.0 + 0.05 * jax.random.normal(ks[2], (DEPTH, D_MODEL), jnp.float32)
    lb_logits = 0.5 * jax.random.normal(ks[3], (DEPTH, A_QF), jnp.float32)
    hgrn_norm_gain = 1.0 + 0.05 * jax.random.normal(ks[4], (DEPTH, A_DV), jnp.float32)
    rel_bias = 0.1 * jax.random.normal(ks[5], (DEPTH, B_HEADS, 2 * REL_CLIP + 1), jnp.float32)
    w_out = jax.random.normal(ks[6], (DEPTH, D_MIX, D_MODEL), jnp.float32) * D_MIX ** -0.5
    final_gain = 1.0 + 0.05 * jax.random.normal(ks[7], (D_MODEL,), jnp.float32)
    return {"x": x, "w_in": w_in, "norm_gain": norm_gain, "lb_logits": lb_logits,
            "hgrn_norm_gain": hgrn_norm_gain, "rel_bias": rel_bias, "w_out": w_out,
            "final_gain": final_gain}


def reference(x, w_in, norm_gain, lb_logits, hgrn_norm_gain, rel_bias, w_out, final_gain):
    s = x.shape[1]
    lb_all = jnp.cumsum(jax.nn.softmax(lb_logits.astype(jnp.float32), axis=0), axis=0)
    lb_all = lb_all - lb_all[0:1]
    inv_freq = ROPE_BASE ** (-jnp.linspace(0.0, 1.0, C_DK // 2, dtype=jnp.float32))
    ang = jnp.arange(s, dtype=jnp.float32)[:, None] * inv_freq[None, :]
    cos, sin = jnp.cos(ang), jnp.sin(ang)
    for layer in range(DEPTH):
        x = hybrid_layer(x, w_in[layer], norm_gain[layer], lb_all[layer], hgrn_norm_gain[layer],
                         rel_bias[layer], w_out[layer], cos, sin)
    return rmsnorm(x, final_gain)
```

```cpp
#include <hip/hip_runtime.h>
#include <hip/hip_cooperative_groups.h>
#include <cstdio>
namespace cg = cooperative_groups;

#define LAS __attribute__((address_space(3)))
typedef unsigned short bf16_t;
typedef short bf16x8 __attribute__((ext_vector_type(8)));
typedef short s16x4 __attribute__((ext_vector_type(4)));
typedef float f32x4 __attribute__((ext_vector_type(4)));
typedef float f32x2 __attribute__((ext_vector_type(2)));
typedef unsigned u32x4 __attribute__((ext_vector_type(4)));
typedef unsigned u32x2 __attribute__((ext_vector_type(2)));

constexpr int NTOK = 32768, SEQ = 16384, DM = 2048, NCHB = 256  , NCH = 512;
constexpr int LDP = 7680;
constexpr int DIN = 7552;
constexpr int AQ = 0, AF = 768, AI = 1536, AG = 2304, BQ = 3072, BKC = 3712, BV = 4352, BG = 4992, CQ = 5632, CK = 5952, CV = 6272, CG = 6912;
constexpr int YA = 0, YB = 768, YC = 1408;
constexpr float EPSN = 1e-6f;

constexpr size_t WS_WIN = 0;
constexpr size_t WS_WOUT = WS_WIN + (size_t)2 * LDP * DM * 2;
constexpr size_t WS_H = WS_WOUT + (size_t)2 * DM * DM * 2;
constexpr size_t WS_PROJ = WS_H + (size_t)NTOK * DM * 2;
constexpr size_t WS_STA = WS_PROJ + (size_t)NTOK * LDP * 2;
constexpr size_t WS_STC = WS_STA + (size_t)NCH * 6 * 128 * 128 * 2;
constexpr size_t WS_DEC = WS_STC + (size_t)NCH * 5 * 128 * 64 * 2;
constexpr size_t WS_CS = WS_DEC + (size_t)NCH * 6 * 128 * 4;
constexpr size_t WS_END = WS_CS + (size_t)SEQ * 32 * 8;
constexpr size_t WS_BARB = 16384;
constexpr size_t WS_D1 = WS_END + WS_BARB;
constexpr size_t WS_TOTAL = WS_D1 + (size_t)NTOK * DM * 2;

struct Params {
    const float *x, *w_in, *norm_gain, *lb_logits, *hg_gain, *rel_bias, *w_out, *final_gain;
    float* out; unsigned char* ws;
    int ph_lo, ph_hi;
};

__device__ __forceinline__ const bf16_t* pjp(const bf16_t* proj, int tcol, int W, int h, size_t tok) { return proj + (size_t)tcol * NTOK + ((size_t)h * NTOK + tok) * W; }
typedef __bf16 bf16x2_t __attribute__((ext_vector_type(2)));
__device__ __forceinline__ unsigned cvt_pk_bf16(float lo, float hi) { const f32x2 f = {lo, hi}; const bf16x2_t v = __builtin_convertvector(f, bf16x2_t); return __builtin_bit_cast(unsigned, v); }
__device__ __forceinline__ bf16_t f2bf(float v) { return (bf16_t)(cvt_pk_bf16(v, 0.f) & 0xffffu); }
__device__ __forceinline__ float bf2f(bf16_t u) { return __uint_as_float((unsigned)u << 16); }
__device__ __forceinline__ float bflo(unsigned u) { return __uint_as_float(u << 16); }
__device__ __forceinline__ float bfhi(unsigned u) { return __uint_as_float(u & 0xffff0000u); }
__device__ __forceinline__ float wave_sum(float v) {
#pragma unroll
    for (int o = 1; o < 64; o <<= 1) v += __shfl_xor(v, o);
    return v;
}
__device__ __forceinline__ float rcp_f(float v) { return __builtin_amdgcn_rcpf(v); }
__device__ __forceinline__ float silu_f(float v) { return v * rcp_f(1.f + __expf(-v)); }

__device__ __forceinline__ unsigned off_b(unsigned row, unsigned ch) { return 256u * row + 16u * (ch ^ (((row & 3u) << 2) | ((row >> 2) & 3u))); }
__device__ __forceinline__ bf16x8 row_frag(LAS unsigned char* tile, int rb, int s, int lane) {
    return *(const LAS bf16x8*)(tile + off_b((unsigned)((lane & 15) + 16 * rb), (unsigned)(4 * s + (lane >> 4))));
}
template <bool PERM>
__device__ __forceinline__ bf16x8 tr_frag(LAS unsigned char* tile, int c, int ks, int lane) {
    const unsigned g = lane >> 4, q = (lane & 15) >> 2, p = lane & 3;
    const unsigned r0 = 32u * ks + (PERM ? 4u * g : 8u * g) + q, r1 = r0 + (PERM ? 16u : 4u);
    const unsigned ch = 2u * c + (p >> 1), sub = 8u * (p & 1);
    const s16x4 a = __builtin_amdgcn_ds_read_tr16_b64_v4i16((LAS s16x4*)(tile + off_b(r0, ch) + sub));
    const s16x4 b = __builtin_amdgcn_ds_read_tr16_b64_v4i16((LAS s16x4*)(tile + off_b(r1, ch) + sub));
    bf16x8 r; r[0] = a[0]; r[1] = a[1]; r[2] = a[2]; r[3] = a[3]; r[4] = b[0]; r[5] = b[1]; r[6] = b[2]; r[7] = b[3]; return r;
}
__device__ __forceinline__ unsigned row_addr(int lane, int s) { return off_b((unsigned)(lane & 15), (unsigned)(4 * s + (lane >> 4))); }
__device__ __forceinline__ bf16x8 row_frag_a(LAS unsigned char* tile, unsigned addr, int rb) { return *(const LAS bf16x8*)(tile + addr + 4096 * rb); }
template <bool PERM>
__device__ __forceinline__ unsigned tr_addr(int lane, int c) { const unsigned g = lane >> 4, q = (lane & 15) >> 2, p = lane & 3;
    return off_b((PERM ? 4u * g : 8u * g) + q, 2u * c + (p >> 1)) + 8u * (p & 1); }
__device__ __forceinline__ unsigned tr_addr_n1(int lane, int c) { const unsigned g = lane >> 4, q = (lane & 15) >> 2, p = lane & 3;
    return off_b(8u * g + 4u + q, 2u * c + (p >> 1)) + 8u * (p & 1); }
__device__ __forceinline__ bf16x8 tr_frag_n(LAS unsigned char* tile, unsigned addr0, unsigned addr1, int ks) {
    const s16x4 a = __builtin_amdgcn_ds_read_tr16_b64_v4i16((LAS s16x4*)(tile + addr0 + 8192 * ks));
    const s16x4 b = __builtin_amdgcn_ds_read_tr16_b64_v4i16((LAS s16x4*)(tile + addr1 + 8192 * ks));
    bf16x8 r; r[0] = a[0]; r[1] = a[1]; r[2] = a[2]; r[3] = a[3]; r[4] = b[0]; r[5] = b[1]; r[6] = b[2]; r[7] = b[3]; return r;
}
template <bool PERM>
__device__ __forceinline__ bf16x8 tr_frag_a(LAS unsigned char* tile, unsigned addr, int ks) {
    static_assert(PERM, "natural order: use tr_frag_n");
    const s16x4 a = __builtin_amdgcn_ds_read_tr16_b64_v4i16((LAS s16x4*)(tile + addr + 8192 * ks));
    const s16x4 b = __builtin_amdgcn_ds_read_tr16_b64_v4i16((LAS s16x4*)(tile + addr + 8192 * ks + (PERM ? 4096 : 1024)));
    bf16x8 r; r[0] = a[0]; r[1] = a[1]; r[2] = a[2]; r[3] = a[3]; r[4] = b[0]; r[5] = b[1]; r[6] = b[2]; r[7] = b[3]; return r;
}
__device__ __forceinline__ f32x4 mfma16(bf16x8 a, bf16x8 b, f32x4 c) { return __builtin_amdgcn_mfma_f32_16x16x32_bf16(a, b, c, 0, 0, 0); }
__device__ __forceinline__ void lds_put(LAS unsigned char* tile, int row, int col, float v) { *(LAS bf16_t*)(tile + off_b((unsigned)row, (unsigned)(col >> 3)) + 2 * (col & 7)) = f2bf(v); }
template <int ROWS, int CH>
__device__ __forceinline__ void tile_load(LAS unsigned char* tile, const bf16_t* src, int ld, int tid) {
#pragma unroll
    for (int u = 0; u < ROWS * CH / 512; ++u) { const int i = tid + 512 * u, row = i / CH, ch = i % CH;
        *(LAS u32x4*)(tile + off_b((unsigned)row, (unsigned)ch)) = *(const u32x4*)(src + (size_t)row * ld + ch * 8); }
}
__device__ __forceinline__ bf16x8 pack8(f32x4 a, f32x4 b) {
    u32x4 w; w.x = cvt_pk_bf16(a[0], a[1]); w.y = cvt_pk_bf16(a[2], a[3]); w.z = cvt_pk_bf16(b[0], b[1]); w.w = cvt_pk_bf16(b[2], b[3]);
    return __builtin_bit_cast(bf16x8, w);
}

namespace pg8 {
constexpr int BM = 256, BK = 64, HALF = 128, HTB = HALF * BK * 2, STAGE_BYTES = 8 * HTB, NXCD = 8, WGM = 8;
__device__ __forceinline__ int lds_byte(int r, int c) { const int st = (r >> 4) * 2 + (c >> 5), rr = r & 15, cc = c & 31, ob = rr * 64 + cc * 2; return st * 1024 + (ob ^ (((ob >> 9) & 1) << 5)); }
__device__ __forceinline__ void stage_rc(int b, int& R, int& C) { const int st = b / 1024, sb = b % 1024, swz = sb ^ (((sb >> 9) & 1) << 5); R = (st >> 1) * 16 + swz / 64; C = (st & 1) * 32 + (swz % 64) / 2; }
__device__ __forceinline__ int perm32(int rho) { const int n = rho >> 4, i = rho & 15; return 8 * (i >> 2) + 4 * n + (i & 3); }
struct Unit { int pm, pn; };
struct Gemm { const bf16_t* A; const bf16_t* Bt; int M, N, K; };
struct StaticOrder {
    int nM, nN, nwg, G, c;
    __device__ void init(int M, int N, int G_, int c_) { nM = M / BM; nN = N / BM; nwg = nM * nN; G = G_; c = c_; }
    __device__ bool next(int i, Unit& u) const {
        const long L = (long)i * G + c; if (L >= nwg) return false;
        int wgid = (int)L; { const int q = nwg / NXCD, r = nwg % NXCD, xcd = wgid % NXCD, off = wgid / NXCD; wgid = (xcd < r ? xcd * (q + 1) : r * (q + 1) + (xcd - r) * q) + off; }
        const int nig = WGM * nN, gid = wgid / nig, fm = gid * WGM, gsz = (nM - fm) < WGM ? (nM - fm) : WGM;
        u.pm = fm + ((wgid % nig) % gsz); u.pn = (wgid % nig) / gsz; return true;
    }
    __device__ __forceinline__ void a_ready(const Unit&) const {}
    __device__ __forceinline__ void done(const Unit&) const {}
};
struct EpiBf16 {
    static constexpr bool PERM = true;
    bf16_t* O; int ldc;
    __device__ __forceinline__ void operator()(const f32x4 (&acc)[2][2][4][2], const Unit& u, int wr, int wc, int fr, int fq) const {
        const int row0 = u.pm * BM + wr * 64 + fr; const int col0 = u.pn * BM + wc * 32 + 8 * fq;
#pragma unroll
        for (int ai = 0; ai < 2; ++ai)
#pragma unroll
            for (int m = 0; m < 4; ++m) { bf16_t* rowp = O + (size_t)(row0 + ai * HALF + m * 16) * ldc + col0;
#pragma unroll
                for (int bj = 0; bj < 2; ++bj) { const f32x4 v0 = acc[ai][bj][m][0], v1 = acc[ai][bj][m][1];
                    u32x4 w; w.x = cvt_pk_bf16(v0[0], v0[1]); w.y = cvt_pk_bf16(v0[2], v0[3]); w.z = cvt_pk_bf16(v1[0], v1[1]); w.w = cvt_pk_bf16(v1[2], v1[3]);
                    *(u32x4*)(rowp + bj * HALF) = w; } }
    }
};

struct EpiProj {
    static constexpr bool PERM = true;
    bf16_t* O;
    __device__ __forceinline__ void operator()(const f32x4 (&acc)[2][2][4][2], const Unit& u, int wr, int wc, int fr, int fq) const {
        const int row0 = u.pm * BM + wr * 64 + fr;
#pragma unroll
        for (int bj = 0; bj < 2; ++bj) { const int c32 = u.pn * BM + bj * HALF + wc * 32;
            if (c32 >= DIN) continue;
            int ts, W = 128;
            if (c32 < AF) ts = AQ; else if (c32 < AI) ts = AF; else if (c32 < AG) ts = AI; else if (c32 < BQ) ts = AG; else if (c32 < BKC) ts = BQ; else if (c32 < BV) ts = BKC;
            else if (c32 < BG) ts = BV; else if (c32 < CQ) ts = BG; else if (c32 < CK) { ts = CQ; W = 64; } else if (c32 < CV) { ts = CK; W = 64; } else if (c32 < CG) ts = CV; else ts = CG;
            const int cp = c32 - ts, h = cp / W, d = cp % W + 8 * fq;
            bf16_t* base = O + (size_t)ts * NTOK + (size_t)h * NTOK * W + d;
#pragma unroll
            for (int ai = 0; ai < 2; ++ai)
#pragma unroll
                for (int m = 0; m < 4; ++m) { const f32x4 v0 = acc[ai][bj][m][0], v1 = acc[ai][bj][m][1];
                    u32x4 w; w.x = cvt_pk_bf16(v0[0], v0[1]); w.y = cvt_pk_bf16(v0[2], v0[3]); w.z = cvt_pk_bf16(v1[0], v1[1]); w.w = cvt_pk_bf16(v1[2], v1[3]);
                    *(u32x4*)(base + (size_t)(row0 + ai * HALF + m * 16) * W) = w; } }
    }
};

template <class Epi, class Sched>
__device__ __forceinline__ void gemm_phase(LAS unsigned char* lds, const Gemm g, const Sched& S, const Epi& E) {
    const int tid = threadIdx.x, wid = __builtin_amdgcn_readfirstlane(tid >> 6), lane = tid & 63, wr = wid >> 2, wc = wid & 3, fr = lane & 15, fq = lane >> 4;
    const int K = g.K, nt = K / BK;
    unsigned voffA[2], voffB[2];
#pragma unroll
    for (int i = 0; i < 2; ++i) { int R, C; stage_rc(tid * 16 + i * 8192, R, C); const int Rb = Epi::PERM ? ((R & ~31) + perm32(R & 31)) : R;
        voffA[i] = (unsigned)(R * K + C) * 2u; voffB[i] = (unsigned)(Rb * K + C) * 2u; }
    const size_t kstep = (size_t)(BK * 2);
    const size_t hstep = (size_t)HALF * K * 2;
    const size_t tstep = 2 * hstep;
    const unsigned ldsw = (unsigned)wid * 1024u;
    const int aoff = lds_byte(wr * 64 + fr, fq * 8), boff = lds_byte(wc * 32 + fr, fq * 8);
#define PG8_SA(b, h) (((b) * 2 + (h)) * HTB)
#define PG8_SB(b, h) ((4 + (b) * 2 + (h)) * HTB)
#define PG8_STAGE(bufoff, gbase, voff) do { _Pragma("unroll") for (int _i = 0; _i < 2; ++_i) \
        __builtin_amdgcn_global_load_lds((const unsigned*)((const char*)(gbase) + (voff)[_i]), (LAS unsigned*)(lds + (bufoff) + ldsw + _i * 8192), 16, 0, 0); } while (0)
#define PG8_LDA(dst, b, h) do { _Pragma("unroll") for (int m = 0; m < 4; ++m) _Pragma("unroll") for (int k = 0; k < 2; ++k) dst[m][k] = *(const LAS bf16x8*)(lds + PG8_SA(b, h) + aoff + m * 2048 + k * 1024); } while (0)
#define PG8_LDB(dst, b, h) do { _Pragma("unroll") for (int n = 0; n < 2; ++n) _Pragma("unroll") for (int k = 0; k < 2; ++k) dst[n][k] = *(const LAS bf16x8*)(lds + PG8_SB(b, h) + boff + n * 2048 + k * 1024); } while (0)
#define PG8_MMA(ai, bj, At, Bt) do { __builtin_amdgcn_s_setprio(1); _Pragma("unroll") for (int m = 0; m < 4; ++m) _Pragma("unroll") for (int n = 0; n < 2; ++n) _Pragma("unroll") for (int k = 0; k < 2; ++k) \
        acc[ai][bj][m][n] = __builtin_amdgcn_mfma_f32_16x16x32_bf16(Bt[n][k], At[m][k], acc[ai][bj][m][n], 0, 0, 0); __builtin_amdgcn_s_setprio(0); } while (0)
#define PG8_WAIT_V(n) asm volatile("s_waitcnt vmcnt(" #n ")" ::: "memory")
#define PG8_WAIT_L(n) asm volatile("s_waitcnt lgkmcnt(" #n ")" ::: "memory")
#define PG8_BAR __builtin_amdgcn_s_barrier()
#define PG8_SCHED __builtin_amdgcn_sched_barrier(0)
    Unit cur, nxt; int ui = 0;
    if (!S.next(0, cur)) return;
    f32x4 acc[2][2][4][2];
#pragma unroll
    for (int a = 0; a < 2; ++a)
#pragma unroll
        for (int b = 0; b < 2; ++b)
#pragma unroll
            for (int m = 0; m < 4; ++m)
#pragma unroll
                for (int n = 0; n < 2; ++n) acc[a][b][m][n] = (f32x4){0.f, 0.f, 0.f, 0.f};
    bf16x8 At[4][2], B0[2][2], B1[2][2];
    const char* cA = (const char*)g.A + (size_t)cur.pm * tstep; const char* cB = (const char*)g.Bt + (size_t)cur.pn * tstep;
    S.a_ready(cur);
    PG8_STAGE(PG8_SB(0, 0), cB, voffB); PG8_STAGE(PG8_SA(0, 0), cA, voffA); PG8_STAGE(PG8_SB(0, 1), cB + hstep, voffB); PG8_STAGE(PG8_SA(0, 1), cA + hstep, voffA);
    if (wr == 1) PG8_BAR;
    PG8_WAIT_V(4); PG8_BAR;
    PG8_STAGE(PG8_SB(1, 0), cB + kstep, voffB); PG8_STAGE(PG8_SA(1, 0), cA + kstep, voffA); PG8_STAGE(PG8_SB(1, 1), cB + hstep + kstep, voffB);
    PG8_WAIT_V(6); PG8_BAR;
    for (;;) {
        const bool has_next = S.next(ui + 1, nxt);
        const char* nA = has_next ? (const char*)g.A + (size_t)nxt.pm * tstep : cA; const char* nB = has_next ? (const char*)g.Bt + (size_t)nxt.pn * tstep : cB;
        for (int t = 0; t < nt; t += 2) {
            const bool last = (t == nt - 2);
            const char* a1 = cA + (size_t)(t + 1) * kstep;
            const char* a2 = last ? nA : cA + (size_t)(t + 2) * kstep; const char* b2 = last ? nB : cB + (size_t)(t + 2) * kstep;
            const char* a3 = a2 + kstep; const char* b3 = b2 + kstep;
            if (last && has_next) S.a_ready(nxt);
            PG8_LDB(B0, 0, 0); PG8_SCHED; PG8_LDA(At, 0, 0); PG8_STAGE(PG8_SA(1, 1), a1 + hstep, voffA);
            PG8_WAIT_L(8); PG8_BAR; PG8_WAIT_L(0); PG8_MMA(0, 0, At, B0); PG8_BAR; PG8_SCHED;
            PG8_LDB(B1, 0, 1); PG8_STAGE(PG8_SB(0, 0), b2, voffB);
            PG8_BAR; PG8_WAIT_L(0); PG8_MMA(0, 1, At, B1); PG8_BAR;
            PG8_LDA(At, 0, 1); PG8_STAGE(PG8_SA(0, 0), a2, voffA);
            PG8_BAR; PG8_WAIT_L(0); PG8_MMA(1, 0, At, B0); PG8_BAR; PG8_SCHED;
            PG8_STAGE(PG8_SB(0, 1), b2 + hstep, voffB);
            PG8_WAIT_V(6); PG8_BAR; PG8_MMA(1, 1, At, B1); PG8_BAR;
            PG8_LDB(B0, 1, 0); PG8_SCHED; PG8_LDA(At, 1, 0); PG8_STAGE(PG8_SA(0, 1), a2 + hstep, voffA);
            PG8_WAIT_L(8); PG8_BAR; PG8_WAIT_L(0); PG8_MMA(0, 0, At, B0); PG8_BAR; PG8_SCHED;
            PG8_LDB(B1, 1, 1); PG8_STAGE(PG8_SB(1, 0), b3, voffB);
            PG8_BAR; PG8_WAIT_L(0); PG8_MMA(0, 1, At, B1); PG8_BAR;
            PG8_LDA(At, 1, 1); PG8_STAGE(PG8_SA(1, 0), a3, voffA);
            PG8_BAR; PG8_WAIT_L(0); PG8_MMA(1, 0, At, B0); PG8_BAR; PG8_SCHED;
            PG8_STAGE(PG8_SB(1, 1), b3 + hstep, voffB);
            PG8_WAIT_V(6); PG8_BAR; PG8_MMA(1, 1, At, B1); PG8_BAR;
        }
        E(acc, cur, wr, wc, fr, fq); S.done(cur);
        if (!has_next) break;
#pragma unroll
        for (int a = 0; a < 2; ++a)
#pragma unroll
            for (int b = 0; b < 2; ++b)
#pragma unroll
                for (int m = 0; m < 4; ++m)
#pragma unroll
                    for (int n = 0; n < 2; ++n) acc[a][b][m][n] = (f32x4){0.f, 0.f, 0.f, 0.f};
        cur = nxt; cA = nA; cB = nB; ++ui;
    }
    PG8_WAIT_V(0);
    if (wr == 0) PG8_BAR;
    PG8_BAR;
#undef PG8_SA
#undef PG8_SB
#undef PG8_STAGE
#undef PG8_LDA
#undef PG8_LDB
#undef PG8_MMA
#undef PG8_WAIT_V
#undef PG8_WAIT_L
#undef PG8_BAR
#undef PG8_SCHED
}
}

#define LDS_WAIT() asm volatile("s_waitcnt lgkmcnt(0)" ::: "memory")
__device__ __forceinline__ void p0_transpose_item(const float* W, int K, int N, bf16_t* WT, LAS float* scr, int item, int lane, bool stream = false) {
    const int nblk = N / 32, kb = item / nblk, nb = item % nblk, k0 = 64 * kb, n0 = 32 * nb;
#pragma unroll 8
    for (int i = 0; i < 32; ++i) { const int kk = 2 * i + (lane >> 5); scr[kk * 33 + (lane & 31)] = W[(size_t)(k0 + kk) * N + n0 + (lane & 31)]; }
    LDS_WAIT(); asm volatile("" ::: "memory");
    const int c = lane & 7;
#pragma unroll
    for (int j = 0; j < 4; ++j) { const int n = (lane >> 3) + 8 * j; const LAS float* s = scr + (8 * c) * 33 + n;
        u32x4 o; o.x = cvt_pk_bf16(s[0 * 33], s[1 * 33]); o.y = cvt_pk_bf16(s[2 * 33], s[3 * 33]); o.z = cvt_pk_bf16(s[4 * 33], s[5 * 33]); o.w = cvt_pk_bf16(s[6 * 33], s[7 * 33]);
        if (stream) __builtin_nontemporal_store(o, (u32x4*)(WT + (size_t)(n0 + n) * K + k0 + 8 * c)); else *(u32x4*)(WT + (size_t)(n0 + n) * K + k0 + 8 * c) = o; }
    LDS_WAIT(); asm volatile("" ::: "memory");
}
template <bool FINAL>
__device__ __forceinline__ void norm_row(int row, const float* src, const bf16_t* d1, const bf16_t* d2, const f32x4 (&gv)[8], bf16_t* dsth, float* dstf, int lane, bf16_t* xb = nullptr) {
    const float* xr = src + (size_t)row * DM;
    f32x4 v[8]; float ss = 0.f;
#pragma unroll
    for (int j = 0; j < 8; ++j) v[j] = *(const f32x4*)(xr + 4 * (lane + 64 * j));
    if (d1) {
#pragma unroll
        for (int j = 0; j < 8; ++j) { const u32x2 a = *(const u32x2*)(d1 + (size_t)row * DM + 4 * (lane + 64 * j));
            v[j][0] += bflo(a.x); v[j][1] += bfhi(a.x); v[j][2] += bflo(a.y); v[j][3] += bfhi(a.y); } }
    if (d2) {
#pragma unroll
        for (int j = 0; j < 8; ++j) { const u32x2 a = *(const u32x2*)(d2 + (size_t)row * DM + 4 * (lane + 64 * j));
            v[j][0] += bflo(a.x); v[j][1] += bfhi(a.x); v[j][2] += bflo(a.y); v[j][3] += bfhi(a.y); } }
    if (xb) {
#pragma unroll
        for (int j = 0; j < 8; ++j) { u32x2 w; w.x = cvt_pk_bf16(v[j][0], v[j][1]); w.y = cvt_pk_bf16(v[j][2], v[j][3]); *(u32x2*)(xb + (size_t)row * DM + 4 * (lane + 64 * j)) = w; } }
#pragma unroll
    for (int j = 0; j < 8; ++j) ss += (v[j][0] * v[j][0] + v[j][1] * v[j][1]) + (v[j][2] * v[j][2] + v[j][3] * v[j][3]);
    const float r = rsqrtf(wave_sum(ss) * (1.f / DM) + EPSN);
#pragma unroll
    for (int j = 0; j < 8; ++j) { const f32x4 o = v[j] * r * gv[j];
        if (FINAL) __builtin_nontemporal_store(o, (f32x4*)(dstf + (size_t)row * DM + 4 * (lane + 64 * j)));
        else { u32x2 w; w.x = cvt_pk_bf16(o[0], o[1]); w.y = cvt_pk_bf16(o[2], o[3]); *(u32x2*)(dsth + (size_t)row * DM + 4 * (lane + 64 * j)) = w; } }
}
__device__ __forceinline__ void phase_final(const bf16_t* a, const bf16_t* b, const float* gain, float* dst, int tid) {
    const int wave = tid >> 6, lane = tid & 63;
    f32x4 gv[8];
#pragma unroll
    for (int j = 0; j < 8; ++j) gv[j] = *(const f32x4*)(gain + 4 * (lane + 64 * j));
    for (int row = blockIdx.x * 8 + wave; row < NTOK; row += gridDim.x * 8) {
        f32x4 v[8]; float ss = 0.f;
#pragma unroll
        for (int j = 0; j < 8; ++j) { const u32x2 p = *(const u32x2*)(a + (size_t)row * DM + 4 * (lane + 64 * j)), q = *(const u32x2*)(b + (size_t)row * DM + 4 * (lane + 64 * j));
            v[j][0] = bflo(p.x) + bflo(q.x); v[j][1] = bfhi(p.x) + bfhi(q.x); v[j][2] = bflo(p.y) + bflo(q.y); v[j][3] = bfhi(p.y) + bfhi(q.y);
            ss += (v[j][0] * v[j][0] + v[j][1] * v[j][1]) + (v[j][2] * v[j][2] + v[j][3] * v[j][3]); }
        const float r = rsqrtf(wave_sum(ss) * (1.f / DM) + EPSN);
#pragma unroll
        for (int j = 0; j < 8; ++j) __builtin_nontemporal_store(v[j] * r * gv[j], (f32x4*)(dst + (size_t)row * DM + 4 * (lane + 64 * j)));
    }
}
template <bool FINAL>
__device__ __forceinline__ void phase_norm(const float* src, const bf16_t* d1, const bf16_t* d2, const float* gain, bf16_t* dsth, float* dstf, int tid, bf16_t* xb = nullptr) {
    const int wave = tid >> 6, lane = tid & 63;
    f32x4 gv[8];
#pragma unroll
    for (int j = 0; j < 8; ++j) gv[j] = *(const f32x4*)(gain + 4 * (lane + 64 * j));
    for (int row = blockIdx.x * 8 + wave; row < NTOK; row += gridDim.x * 8) norm_row<FINAL>(row, src, d1, d2, gv, dsth, dstf, lane, xb);
}

__device__ __forceinline__ void phase_prep(const Params& P, LAS unsigned char* lds, int tid) {
    const int wave = tid >> 6, lane = tid & 63;
    LAS float* scr = (LAS float*)(lds + wave * 8704);
    const int gw = blockIdx.x * 8 + wave, NGW = gridDim.x * 8;
    constexpr int I_IN = (DM / 64) * (DIN / 32), I_OUT = (DM / 64) * (DM / 32);
    bf16_t* win = (bf16_t*)(P.ws + WS_WIN); bf16_t* wout = (bf16_t*)(P.ws + WS_WOUT);
    static_assert(2 * (I_IN + I_OUT) == 256 * 75 && NTOK == 256 * 128, "interleave pattern");
    f32x4 gv[8];
#pragma unroll
    for (int j = 0; j < 8; ++j) gv[j] = *(const f32x4*)(P.norm_gain + 4 * (lane + 64 * j));
    for (int u = gw; u < 256 * 203; u += NGW) {
        const int q = u / 203, rr = u % 203;
        if (rr >= 75) { norm_row<false>(q * 128 + (rr - 75), P.x, nullptr, nullptr, gv, (bf16_t*)(P.ws + WS_H), nullptr, lane); continue; }
        int r = q * 75 + rr;
        if (r < 2 * I_IN) { const int l = r / I_IN; r -= l * I_IN; p0_transpose_item(P.w_in + (size_t)l * DM * DIN, DM, DIN, win + (size_t)l * LDP * DM, scr, r, lane, l != 0); }
        else { r -= 2 * I_IN; const int l = r / I_OUT; r -= l * I_OUT; p0_transpose_item(P.w_out + (size_t)l * DM * DM, DM, DM, wout + (size_t)l * DM * DM, scr, r, lane, l != 0); }
    }
    const int gt = blockIdx.x * 512 + tid, NT = gridDim.x * 512;
    for (int i = gt; i < 2 * 32768; i += NT) { const int l = i >> 15, c = i & 32767; *(u32x4*)(win + (size_t)l * LDP * DM + (size_t)DIN * DM + (size_t)c * 8) = (u32x4){0u, 0u, 0u, 0u}; }
    float2* cs = (float2*)(P.ws + WS_CS);
    for (int i = gt; i < SEQ * 32; i += NT) { const int pos = i >> 5, f = i & 31;
        const float inv = exp2f(-(float)f * (13.287712379549449f / 31.0f));
        const float ang = (float)pos * inv;
        double rev = (double)ang * 0.15915494309189535; rev -= floor(rev);
        const float fr = (float)rev;
        cs[i] = make_float2(__builtin_amdgcn_cosf(fr), __builtin_amdgcn_sinf(fr)); }
}

constexpr int L_T0 = 0, L_T1 = 16384, L_T2 = 32768, L_T3 = 49152, L_T4 = 65536, L_AUX = 98304;

template <int DK>
__device__ __forceinline__ void ds_core(LAS unsigned char* kd, LAS unsigned char* vt, bf16_t* ST, int w, int lane) {
    const int g = lane >> 4, c15 = lane & 15;
    constexpr int NVB = (DK == 128) ? 8 : 4;
    const int kb = (DK == 128) ? w : (w & 3), vb0 = (DK == 128) ? 0 : 4 * (w >> 2);
    const unsigned ka = tr_addr<false>(lane, kb), ka1 = tr_addr_n1(lane, kb);
    bf16x8 a[2], vf[2][NVB];
#pragma unroll
    for (int ks = 0; ks < 2; ++ks) { a[ks] = tr_frag_n(kd, ka, ka1, ks);
#pragma unroll
        for (int i = 0; i < NVB; ++i) vf[ks][i] = tr_frag_n(vt, tr_addr<false>(lane, vb0 + i), tr_addr_n1(lane, vb0 + i), ks); }
    f32x4 acc[NVB];
#pragma unroll
    for (int i = 0; i < NVB; ++i) acc[i] = (f32x4){0.f, 0.f, 0.f, 0.f};
#pragma unroll
    for (int ks = 0; ks < 2; ++ks)
#pragma unroll
        for (int i = 0; i < NVB; ++i) acc[i] = mfma16(a[ks], vf[ks][i], acc[i]);
#pragma unroll
    for (int i = 0; i < NVB; ++i) { const int vb = vb0 + i;
        u32x2 o; o.x = cvt_pk_bf16(acc[i][0], acc[i][1]); o.y = cvt_pk_bf16(acc[i][2], acc[i][3]);
        *(u32x2*)(ST + (size_t)(16 * vb + c15) * DK + 16 * kb + 4 * g) = o; }
}

template <int DK, bool ISC>
__device__ __forceinline__ void out_core(LAS unsigned char* qs, LAS unsigned char* ks, LAS unsigned char* qi, LAS unsigned char* vt, LAS unsigned char* st, LAS float* red,
                                         float gl2, LAS unsigned char* gate, const float* gain, bf16_t* y, int w, int lane) {
    constexpr int KS = DK / 32;
    const int tb = w & 3, vh = w >> 2, g = lane >> 4, c15 = lane & 15, t = 16 * tb + c15;
    unsigned ra[KS];
#pragma unroll
    for (int kk = 0; kk < KS; ++kk) ra[kk] = row_addr(lane, kk);
    bf16x8 qf[KS], qif[KS];
#pragma unroll
    for (int kk = 0; kk < KS; ++kk) qf[kk] = row_frag_a(qs, ra[kk], tb);
    f32x4 accs[4];
#pragma unroll
    for (int sb = 0; sb < 4; ++sb) accs[sb] = (f32x4){0.f, 0.f, 0.f, 0.f};
    {   bf16x8 kf[2][4];
#pragma unroll
        for (int sb = 0; sb < 4; ++sb) kf[0][sb] = row_frag_a(ks, ra[0], sb);
#pragma unroll
        for (int kk = 0; kk < KS; ++kk) {
            if (kk + 1 < KS) {
#pragma unroll
                for (int sb = 0; sb < 4; ++sb) kf[(kk + 1) & 1][sb] = row_frag_a(ks, ra[kk + 1 < KS ? kk + 1 : 0], sb); }
#pragma unroll
            for (int sb = 0; sb < 4; ++sb) accs[sb] = mfma16(kf[kk & 1][sb], qf[kk], accs[sb]); } }
#pragma unroll
    for (int kk = 0; kk < KS; ++kk) qif[kk] = row_frag_a(qi, ra[kk], tb);
    unsigned va[4];
#pragma unroll
    for (int i = 0; i < 4; ++i) va[i] = tr_addr<true>(lane, vh * 4 + i);
    constexpr int NS = 2 + KS;
    bf16x8 fa[2][4];
#pragma unroll
    for (int i = 0; i < 4; ++i) fa[0][i] = tr_frag_a<true>(vt, va[i], 0);
#pragma unroll
    for (int sb = 0; sb < 4; ++sb)
#pragma unroll
        for (int r = 0; r < 4; ++r) { const int s = 16 * sb + 4 * g + r; float v = accs[sb][r];
            if (ISC) v *= exp2f(gl2 * (float)(t - s));
            accs[sb][r] = (s <= t) ? v : 0.f; }
    bf16x8 pf[2]; pf[0] = pack8(accs[0], accs[1]); pf[1] = pack8(accs[2], accs[3]);
    f32x4 acco[4]; float ss = 0.f;
#pragma unroll
    for (int i = 0; i < 4; ++i) acco[i] = (f32x4){0.f, 0.f, 0.f, 0.f};
#pragma unroll
    for (int s = 0; s < NS; ++s) {
        if (s + 1 < NS) {
#pragma unroll
            for (int i = 0; i < 4; ++i) fa[(s + 1) & 1][i] = (s + 1 < 2) ? tr_frag_a<true>(vt, va[i], 1) : row_frag_a(st, ra[(s + 1 >= 2 && s + 1 < NS) ? s - 1 : 0], vh * 4 + i); }
        const bf16x8 bop = (s < 2) ? pf[s < 2 ? s : 0] : qif[(s >= 2) ? s - 2 : 0];
#pragma unroll
        for (int i = 0; i < 4; ++i) acco[i] = mfma16(fa[s & 1][i], bop, acco[i]); }
#pragma unroll
    for (int i = 0; i < 4; ++i) ss += (acco[i][0] * acco[i][0] + acco[i][1] * acco[i][1]) + (acco[i][2] * acco[i][2] + acco[i][3] * acco[i][3]);
    ss += __shfl_xor(ss, 16); ss += __shfl_xor(ss, 32);
    if (g == 0) red[vh * 64 + t] = ss;
    u32x2 gtv[4];
#pragma unroll
    for (int i = 0; i < 4; ++i) gtv[i] = *(const LAS u32x2*)(gate + t * 256 + 2 * (16 * (vh * 4 + i) + 4 * g));
    __syncthreads();
    const float rinv = rsqrtf((red[t] + red[64 + t]) * (1.f / 128.f) + EPSN);
#pragma unroll
    for (int i = 0; i < 4; ++i) { const int v0 = 16 * (vh * 4 + i) + 4 * g;
        const u32x2 gt2 = gtv[i];
        f32x4 gn = (f32x4){1.f, 1.f, 1.f, 1.f}; if (!ISC) gn = *(const f32x4*)(gain + v0);
        const float o0 = acco[i][0] * rinv * gn[0] * silu_f(bflo(gt2.x)), o1 = acco[i][1] * rinv * gn[1] * silu_f(bfhi(gt2.x));
        const float o2 = acco[i][2] * rinv * gn[2] * silu_f(bflo(gt2.y)), o3 = acco[i][3] * rinv * gn[3] * silu_f(bfhi(gt2.y));
        u32x2 o; o.x = cvt_pk_bf16(o0, o1); o.y = cvt_pk_bf16(o2, o3);
        *(u32x2*)(y + (size_t)t * DM + v0) = o; }
}

__device__ __forceinline__ float lb_of(const Params& P, int layer, int k) {
    if (layer == 0) return 0.f;
    const float l0 = P.lb_logits[k], l1 = P.lb_logits[768 + k];
    return rcp_f(1.f + __expf(l0 - l1));
}

constexpr int R_Z = 0, R_Q = 16384, R_2 = 32768, R_V = 49152, R_ST = 65536, R_G = 98304, R_AUX = 131072;
__device__ __forceinline__ void raw_put(LAS unsigned char* reg, int i, u32x4 v) { *(LAS u32x4*)(reg + (i >> 4) * 256 + (i & 15) * 16) = v; }
__device__ __forceinline__ void swz_put(LAS unsigned char* reg, int i, u32x4 v) { *(LAS u32x4*)(reg + off_b((unsigned)(i >> 4), (unsigned)(i & 15))) = v; }
__device__ __forceinline__ float raw_get(LAS unsigned char* reg, int row, int col) { return bf2f(*(const LAS bf16_t*)(reg + row * 256 + 2 * col)); }

struct A1Regs { u32x4 z[2], v[2]; };
__device__ __forceinline__ void a1_load(A1Regs& R, const Params& P, int item, int tid) {
    const int cidx = item / 6, h = item % 6; const bf16_t* proj = (const bf16_t*)(P.ws + WS_PROJ);
#pragma unroll
    for (int u = 0; u < 2; ++u) { const int i = tid + 512 * u; const size_t o = (size_t)(cidx * 64 + (i >> 4)) * 128 + (i & 15) * 8;
        R.z[u] = *(const u32x4*)(pjp(proj, AF, 128, h, 0) + o); R.v[u] = *(const u32x4*)(pjp(proj, AI, 128, h, 0) + o); }
}
__device__ __forceinline__ void a1_phase(const Params& P, int layer, LAS unsigned char* lds, int tid) {
    const int w = tid >> 6, lane = tid & 63, kp = tid & 63, G = gridDim.x;
    LAS float* part = (LAS float*)(lds + R_AUX);
    A1Regs R; int it = blockIdx.x; if (it < 3072) a1_load(R, P, it, tid);
    for (; it < 3072; it += G) {
        const int cidx = it / 6, h = it % 6;
        const float lb0 = lb_of(P, layer, h * 128 + 2 * kp), lb1 = lb_of(P, layer, h * 128 + 2 * kp + 1), om0 = 1.f - lb0, om1 = 1.f - lb1;
#pragma unroll
        for (int u = 0; u < 2; ++u) { raw_put(lds + R_Q, tid + 512 * u, R.z[u]); swz_put(lds + R_V, tid + 512 * u, R.v[u]); }
        __syncthreads();
        if (it + G < 3072) a1_load(R, P, it + G, tid);
        float f0[8], f1[8]; float t0 = 1.f, t1 = 1.f;
#pragma unroll
        for (int i = 0; i < 8; ++i) { const unsigned zz = *(const LAS unsigned*)(lds + R_Q + (8 * w + i) * 256 + 4 * kp);
            f0[i] = lb0 + om0 * rcp_f(1.f + __expf(-bflo(zz))); f1[i] = lb1 + om1 * rcp_f(1.f + __expf(-bfhi(zz))); t0 *= f0[i]; t1 *= f1[i]; }
        *(LAS f32x2*)(part + w * 128 + 2 * kp) = (f32x2){t0, t1};
        __syncthreads();
        float s0 = 1.f, s1 = 1.f, p0 = 1.f, p1 = 1.f;
#pragma unroll
        for (int g2 = 0; g2 < 8; ++g2) { const f32x2 tv = *(const LAS f32x2*)(part + g2 * 128 + 2 * kp); p0 *= tv[0]; p1 *= tv[1]; if (g2 > w) { s0 *= tv[0]; s1 *= tv[1]; } }
#pragma unroll
        for (int i = 7; i >= 0; --i) { const int row = 8 * w + i;
            *(LAS unsigned*)(lds + R_Z + off_b((unsigned)row, (unsigned)(kp >> 2)) + 4 * (kp & 3)) = cvt_pk_bf16((1.f - f0[i]) * s0, (1.f - f1[i]) * s1);
            s0 *= f0[i]; s1 *= f1[i]; }
        if (w == 0) *(f32x2*)((float*)(P.ws + WS_DEC) + (size_t)(cidx * 6 + h) * 128 + 2 * kp) = (f32x2){p0, p1};
        __syncthreads();
        ds_core<128>(lds + R_Z, lds + R_V, (bf16_t*)(P.ws + WS_STA) + (size_t)(cidx * 6 + h) * 16384, w, lane);
        __syncthreads();
    }
}
struct A3Regs { u32x4 z[2], q[2], v[2], g[2], st[4]; };
__device__ __forceinline__ void a3_load(A3Regs& R, const Params& P, int item, int tid) {
    const int cidx = item / 6, h = item % 6; const bf16_t* proj = (const bf16_t*)(P.ws + WS_PROJ);
#pragma unroll
    for (int u = 0; u < 2; ++u) { const int i = tid + 512 * u; const size_t o = (size_t)(cidx * 64 + (i >> 4)) * 128 + (i & 15) * 8;
        R.z[u] = *(const u32x4*)(pjp(proj, AF, 128, h, 0) + o); R.q[u] = *(const u32x4*)(pjp(proj, AQ, 128, h, 0) + o); R.v[u] = *(const u32x4*)(pjp(proj, AI, 128, h, 0) + o); R.g[u] = *(const u32x4*)(pjp(proj, AG, 128, h, 0) + o); }
    const bf16_t* st = (const bf16_t*)(P.ws + WS_STA) + (size_t)(cidx * 6 + h) * 16384;
#pragma unroll
    for (int u = 0; u < 4; ++u) R.st[u] = *(const u32x4*)(st + (size_t)(tid + 512 * u) * 8);
}
__device__ __forceinline__ void a3_phase(const Params& P, int layer, LAS unsigned char* lds, int tid) {
    const int w = tid >> 6, lane = tid & 63, kp = tid & 63, G = gridDim.x;
    LAS float* part = (LAS float*)(lds + R_AUX);
    A3Regs R; int it = blockIdx.x; if (it < 3072) a3_load(R, P, it, tid);
    for (; it < 3072; it += G) {
        const int cidx = it / 6, h = it % 6, tok0 = cidx * 64;
        const float lb0 = lb_of(P, layer, h * 128 + 2 * kp), lb1 = lb_of(P, layer, h * 128 + 2 * kp + 1), om0 = 1.f - lb0, om1 = 1.f - lb1;
#pragma unroll
        for (int u = 0; u < 2; ++u) { const int i = tid + 512 * u; raw_put(lds + R_Z, i, R.z[u]); raw_put(lds + R_Q, i, R.q[u]); swz_put(lds + R_V, i, R.v[u]); raw_put(lds + R_G, i, R.g[u]); }
#pragma unroll
        for (int u = 0; u < 4; ++u) swz_put(lds + R_ST, tid + 512 * u, R.st[u]);
        __syncthreads();
        if (it + G < 3072) a3_load(R, P, it + G, tid);
        float f0[8], f1[8], q0[8], q1[8]; float t0 = 1.f, t1 = 1.f;
#pragma unroll
        for (int i = 0; i < 8; ++i) { const unsigned zz = *(const LAS unsigned*)(lds + R_Z + (8 * w + i) * 256 + 4 * kp), qq = *(const LAS unsigned*)(lds + R_Q + (8 * w + i) * 256 + 4 * kp);
            f0[i] = lb0 + om0 * rcp_f(1.f + __expf(-bflo(zz))); f1[i] = lb1 + om1 * rcp_f(1.f + __expf(-bfhi(zz))); t0 *= f0[i]; t1 *= f1[i];
            q0[i] = silu_f(bflo(qq)) * 0.08838834764831845f; q1[i] = silu_f(bfhi(qq)) * 0.08838834764831845f; }
        *(LAS f32x2*)(part + w * 128 + 2 * kp) = (f32x2){t0, t1};
        __syncthreads();
        float p0 = 1.f, p1 = 1.f, x0 = 1.f, x1 = 1.f;
#pragma unroll
        for (int g2 = 0; g2 < 8; ++g2) { const f32x2 tv = *(const LAS f32x2*)(part + g2 * 128 + 2 * kp);
            if (g2 < w) { p0 *= tv[0]; p1 *= tv[1]; }
            if ((w < 4) ? (g2 > w && g2 < 4) : (g2 >= 4 && g2 < w)) { x0 *= tv[0]; x1 *= tv[1]; } }
#define A3_PUT(REG, ROW, VA, VB) *(LAS unsigned*)(lds + (REG) + off_b((unsigned)(ROW), (unsigned)(kp >> 2)) + 4 * (kp & 3)) = cvt_pk_bf16((VA), (VB))
        if (w >= 4) {
#pragma unroll
            for (int i = 0; i < 8; ++i) { const int row = 8 * w + i; p0 *= f0[i]; p1 *= f1[i]; x0 *= f0[i]; x1 *= f1[i];
                A3_PUT(R_2, row, q0[i] * p0, q1[i] * p1);
                A3_PUT(R_Z, row, q0[i] * x0, q1[i] * x1);
                A3_PUT(R_Q, row, (1.f - f0[i]) * rcp_f(fmaxf(x0, 1e-35f)), (1.f - f1[i]) * rcp_f(fmaxf(x1, 1e-35f))); }
        } else {
#pragma unroll
            for (int i = 0; i < 8; ++i) { p0 *= f0[i]; p1 *= f1[i]; A3_PUT(R_2, 8 * w + i, q0[i] * p0, q1[i] * p1); }
#pragma unroll
            for (int i = 7; i >= 0; --i) { const int row = 8 * w + i;
                A3_PUT(R_Z, row, q0[i] * rcp_f(fmaxf(x0, 1e-35f)), q1[i] * rcp_f(fmaxf(x1, 1e-35f)));
                A3_PUT(R_Q, row, (1.f - f0[i]) * x0, (1.f - f1[i]) * x1);
                x0 *= f0[i]; x1 *= f1[i]; }
        }
#undef A3_PUT
        __syncthreads();
        out_core<128, false>(lds + R_Z, lds + R_Q, lds + R_2, lds + R_V, lds + R_ST, part + 1024, 0.f,
                             lds + R_G, P.hg_gain + layer * 128, (bf16_t*)(P.ws + WS_H) + (size_t)tok0 * DM + YA + h * 128, w, lane);
    }
}
__device__ __forceinline__ float c_gl2(int h) { return log2f(1.f - exp2f(-5.f - (float)h)); }
struct C1Regs { u32x4 kq, v[2]; f32x4 cs[2]; };
__device__ __forceinline__ void c_load_cs(f32x4 (&csr)[2], const Params& P, int n, int tid) {
    const float* cs = (const float*)(P.ws + WS_CS);
#pragma unroll
    for (int u = 0; u < 2; ++u) csr[u] = *(const f32x4*)(cs + ((size_t)(n * 64 + (tid >> 4) + 32 * u) * 32 + 2 * (tid & 15)) * 2);
}
#define C_PUT(REG, ROW, COL, VA, VB) *(LAS unsigned*)(lds + (REG) + off_b((unsigned)(ROW), (unsigned)((COL) >> 3)) + 2 * ((COL) & 7)) = cvt_pk_bf16((VA), (VB))
__device__ __forceinline__ void c1_load(C1Regs& R, const Params& P, int item, int tid) {
    const int cidx = item / 5, h = item % 5, n = cidx & 255; const bf16_t* proj = (const bf16_t*)(P.ws + WS_PROJ);
    R.kq = *(const u32x4*)(pjp(proj, CK, 64, h, cidx * 64 + (tid >> 3)) + (tid & 7) * 8);
#pragma unroll
    for (int u = 0; u < 2; ++u) { const int i = tid + 512 * u; R.v[u] = *(const u32x4*)(pjp(proj, CV, 128, h, cidx * 64 + (i >> 4)) + (i & 15) * 8); }
    c_load_cs(R.cs, P, n, tid);
}
__device__ __forceinline__ void c1_phase(const Params& P, LAS unsigned char* lds, int tid) {
    const int w = tid >> 6, lane = tid & 63, ip = tid & 15, i0 = 2 * ip, r0 = tid >> 4, G = gridDim.x;
    C1Regs R; int it = blockIdx.x; if (it < 2560) c1_load(R, P, it, tid);
    for (; it < 2560; it += G) {
        const int cidx = it / 5, h = it % 5; const float gl2 = c_gl2(h);
        *(LAS u32x4*)(lds + R_Q + (tid >> 3) * 256 + (tid & 7) * 16) = R.kq;
#pragma unroll
        for (int u = 0; u < 2; ++u) swz_put(lds + R_V, tid + 512 * u, R.v[u]);
        f32x4 cs[2];
#pragma unroll
        for (int u = 0; u < 2; ++u) cs[u] = R.cs[u];
        __syncthreads();
        if (it + G < 2560) c1_load(R, P, it + G, tid);
#pragma unroll
        for (int u = 0; u < 2; ++u) { const int j = r0 + 32 * u; const f32x4 c = cs[u];
            const unsigned klo = *(const LAS unsigned*)(lds + R_Q + j * 256 + 4 * ip), khi = *(const LAS unsigned*)(lds + R_Q + j * 256 + 64 + 4 * ip);
            const float sc = 0.125f * exp2f(gl2 * (float)(63 - j));
            const float a1 = bflo(klo), a2 = bflo(khi), b1 = bfhi(klo), b2 = bfhi(khi);
            C_PUT(R_Z, j, i0, (a1 * c[0] - a2 * c[1]) * sc, (b1 * c[2] - b2 * c[3]) * sc);
            C_PUT(R_Z, j, 32 + i0, (a1 * c[1] + a2 * c[0]) * sc, (b1 * c[3] + b2 * c[2]) * sc); }
        __syncthreads();
        ds_core<64>(lds + R_Z, lds + R_V, (bf16_t*)(P.ws + WS_STC) + (size_t)(cidx * 5 + h) * 8192, w, lane);
        __syncthreads();
    }
}
struct C3Regs { u32x4 q, kk, v[2], g[2], st[2]; f32x4 cs[2]; };
__device__ __forceinline__ void c3_load(C3Regs& R, const Params& P, int item, int tid) {
    const int cidx = item / 5, h = item % 5, n = cidx & 255; const bf16_t* proj = (const bf16_t*)(P.ws + WS_PROJ);
    { const size_t o = (size_t)(cidx * 64 + (tid >> 3)) * 64 + (tid & 7) * 8; R.q = *(const u32x4*)(pjp(proj, CQ, 64, h, 0) + o); R.kk = *(const u32x4*)(pjp(proj, CK, 64, h, 0) + o); }
#pragma unroll
    for (int u = 0; u < 2; ++u) { const int i = tid + 512 * u; const size_t o = (size_t)(cidx * 64 + (i >> 4)) * 128 + (i & 15) * 8;
        R.v[u] = *(const u32x4*)(pjp(proj, CV, 128, h, 0) + o); R.g[u] = *(const u32x4*)(pjp(proj, CG, 128, h, 0) + o); }
    const bf16_t* st = (const bf16_t*)(P.ws + WS_STC) + (size_t)(cidx * 5 + h) * 8192;
#pragma unroll
    for (int u = 0; u < 2; ++u) R.st[u] = *(const u32x4*)(st + (size_t)(tid + 512 * u) * 8);
    c_load_cs(R.cs, P, n, tid);
}
__device__ __forceinline__ void c3_phase(const Params& P, LAS unsigned char* lds, int tid) {
    const int w = tid >> 6, lane = tid & 63, ip = tid & 15, i0 = 2 * ip, r0 = tid >> 4, G = gridDim.x;
    C3Regs R; int it = blockIdx.x; if (it < 2560) c3_load(R, P, it, tid);
    for (; it < 2560; it += G) {
        const int cidx = it / 5, h = it % 5, tok0 = cidx * 64; const float gl2 = c_gl2(h);
        *(LAS u32x4*)(lds + R_G + 16384 + (tid >> 3) * 256 + (tid & 7) * 16) = R.q;
        *(LAS u32x4*)(lds + R_G + 16384 + (tid >> 3) * 256 + 128 + (tid & 7) * 16) = R.kk;
#pragma unroll
        for (int u = 0; u < 2; ++u) { const int c = tid + 512 * u; swz_put(lds + R_V, c, R.v[u]); raw_put(lds + R_G, c, R.g[u]);
            *(LAS u32x4*)(lds + R_ST + off_b((unsigned)(c >> 3), (unsigned)(c & 7))) = R.st[u]; }
        f32x4 cs[2];
#pragma unroll
        for (int u = 0; u < 2; ++u) cs[u] = R.cs[u];
        __syncthreads();
        if (it + G < 2560) c3_load(R, P, it + G, tid);
        LAS unsigned char* rqk = lds + R_G + 16384;
#pragma unroll
        for (int u = 0; u < 2; ++u) { const int j = r0 + 32 * u; const f32x4 c = cs[u];
            const unsigned qlo = *(const LAS unsigned*)(rqk + j * 256 + 4 * ip), qhi = *(const LAS unsigned*)(rqk + j * 256 + 64 + 4 * ip);
            const unsigned klo = *(const LAS unsigned*)(rqk + j * 256 + 128 + 4 * ip), khi = *(const LAS unsigned*)(rqk + j * 256 + 192 + 4 * ip);
            const float dq = exp2f(gl2 * (float)(j + 1));
            const float qa0 = bflo(qlo) * c[0] - bflo(qhi) * c[1], qb0 = bflo(qlo) * c[1] + bflo(qhi) * c[0];
            const float qa1 = bfhi(qlo) * c[2] - bfhi(qhi) * c[3], qb1 = bfhi(qlo) * c[3] + bfhi(qhi) * c[2];
            C_PUT(R_Z, j, i0, qa0, qa1); C_PUT(R_Z, j, 32 + i0, qb0, qb1);
            C_PUT(R_2, j, i0, qa0 * dq, qa1 * dq); C_PUT(R_2, j, 32 + i0, qb0 * dq, qb1 * dq);
            C_PUT(R_Q, j, i0, (bflo(klo) * c[0] - bflo(khi) * c[1]) * 0.125f, (bfhi(klo) * c[2] - bfhi(khi) * c[3]) * 0.125f);
            C_PUT(R_Q, j, 32 + i0, (bflo(klo) * c[1] + bflo(khi) * c[0]) * 0.125f, (bfhi(klo) * c[3] + bfhi(khi) * c[2]) * 0.125f); }
        __syncthreads();
        out_core<64, true>(lds + R_Z, lds + R_Q, lds + R_2, lds + R_V, lds + R_ST, (LAS float*)(lds + R_AUX) + 512, gl2,
                           lds + R_G, nullptr, (bf16_t*)(P.ws + WS_H) + (size_t)tok0 * DM + YC + h * 128, w, lane);
    }
}
#undef C_PUT

__device__ __forceinline__ void b_item(const Params& P, int layer, LAS unsigned char* lds, int item, int tid) {
    const int b = item / 320, rem = item % 320, h = rem / 64, m = rem % 64, w = tid >> 6, lane = tid & 63;
    const int qc = w >> 1, th = w & 1, g = lane >> 4, c15 = lane & 15;
    const bf16_t* proj = (const bf16_t*)(P.ws + WS_PROJ);
    const size_t tok0 = (size_t)b * SEQ + (size_t)m * 256;
    LAS unsigned char* Qt = lds + 0; LAS unsigned char* KV = lds + 65536; LAS float* bias = (LAS float*)(lds + 131072);
    tile_load<256, 16>(Qt, pjp(proj, BQ, 128, h, tok0), 128, tid);
    for (int i = tid; i < 257; i += 512) bias[i] = P.rel_bias[(size_t)(layer * 5 + h) * 257 + i];
    const int jst = (8 - 4 * m) > 0 ? (8 - 4 * m) : 0;
    const long krow = (long)b * SEQ + (long)(4 * m - 8) * 64;
    const bf16_t* kbase = pjp(proj, BKC, 128, h, 0) + krow * 128; const bf16_t* vbase = pjp(proj, BV, 128, h, 0) + krow * 128;
    unsigned soff[2];
#pragma unroll
    for (int u = 0; u < 2; ++u) { const unsigned i = tid + 512 * u, row = i >> 4, ch = (i & 15) ^ (((row & 3u) << 2) | ((row >> 2) & 3u)); soff[u] = row * 128 + ch * 8; }
    const unsigned ldsw = (unsigned)__builtin_amdgcn_readfirstlane(w) * 1024u;
#define B_DMA(J, BUF) do { const long jo_ = (long)(J) * 64 * 128; _Pragma("unroll") for (int u = 0; u < 2; ++u) { \
        __builtin_amdgcn_global_load_lds((const unsigned*)(kbase + jo_ + soff[u]), (LAS unsigned*)(KV + (BUF) * 32768 + ldsw + u * 8192), 16, 0, 0); \
        __builtin_amdgcn_global_load_lds((const unsigned*)(vbase + jo_ + soff[u]), (LAS unsigned*)(KV + (BUF) * 32768 + 16384 + ldsw + u * 8192), 16, 0, 0); } } while (0)
    B_DMA(jst, 0);
    __syncthreads();
    LAS unsigned char* Qw = Qt + 4096 * (qc * 4 + th * 2);
    float mrun[2] = {-1e30f, -1e30f}, lrun[2] = {0.f, 0.f}; const float bfar = bias[256];
    unsigned kaddr[4], vaddr[8];
#pragma unroll
    for (int kk = 0; kk < 4; ++kk) kaddr[kk] = row_addr(lane, kk);
#pragma unroll
    for (int vb = 0; vb < 8; ++vb) vaddr[vb] = tr_addr<true>(lane, vb);
    f32x4 acco[2][8];
#pragma unroll
    for (int u = 0; u < 2; ++u)
#pragma unroll
        for (int i = 0; i < 8; ++i) acco[u][i] = (f32x4){0.f, 0.f, 0.f, 0.f};
    auto step = [&](int j, LAS unsigned char* Kt, LAS unsigned char* Vt) {
        const bool active = (j >= qc) && (j <= qc + 8);
        if (active) {
            const int dl = 64 * (8 + qc - j);
            f32x4 accs[2][4];
#pragma unroll
            for (int sb = 0; sb < 4; ++sb) { accs[0][sb] = (f32x4){0.f, 0.f, 0.f, 0.f}; accs[1][sb] = (f32x4){0.f, 0.f, 0.f, 0.f}; }
            __builtin_amdgcn_s_setprio(1);
#pragma unroll
            for (int kk = 0; kk < 4; ++kk) { const bf16x8 q0 = row_frag_a(Qw, kaddr[kk], 0), q1 = row_frag_a(Qw, kaddr[kk], 1);
#pragma unroll
                for (int sb = 0; sb < 4; ++sb) { const bf16x8 kf = row_frag_a(Kt, kaddr[kk], sb);
                    accs[0][sb] = mfma16(kf, q0, accs[0][sb]); accs[1][sb] = mfma16(kf, q1, accs[1][sb]); } }
            __builtin_amdgcn_s_setprio(0);
            bf16x8 pf[2][2]; float alpha[2];
#pragma unroll
            for (int u = 0; u < 2; ++u) { const int t = 32 * th + 16 * u + c15; float mt = -1e30f;
#pragma unroll
                for (int sb = 0; sb < 4; ++sb) {
                    if (dl >= 192) {
#pragma unroll
                        for (int r = 0; r < 4; ++r) { const float xv = accs[u][sb][r] * 0.08838834764831845f + bfar; accs[u][sb][r] = xv; mt = fmaxf(mt, xv); }
                    } else {
#pragma unroll
                        for (int r = 0; r < 4; ++r) { const int s = 16 * sb + 4 * g + r; int rel = t - s + dl; rel = rel > 128 ? 128 : rel;
                            const float xv = accs[u][sb][r] * 0.08838834764831845f + bias[rel + 128]; accs[u][sb][r] = xv; mt = fmaxf(mt, xv); } } }
                mt = fmaxf(mt, __shfl_xor(mt, 16)); mt = fmaxf(mt, __shfl_xor(mt, 32));
                float mn;
                if (__all(mt <= mrun[u] + 8.f)) { mn = mrun[u]; alpha[u] = 1.f; }
                else { mn = fmaxf(mrun[u], mt); alpha[u] = __expf(mrun[u] - mn); mrun[u] = mn; }
                float ls = 0.f;
#pragma unroll
                for (int sb = 0; sb < 4; ++sb)
#pragma unroll
                    for (int r = 0; r < 4; ++r) { const float pe = __expf(accs[u][sb][r] - mn); accs[u][sb][r] = pe; ls += pe; }
                lrun[u] = lrun[u] * alpha[u] + ls;
                pf[u][0] = pack8(accs[u][0], accs[u][1]); pf[u][1] = pack8(accs[u][2], accs[u][3]); }
            const bool resc = __any(alpha[0] != 1.f || alpha[1] != 1.f);
            __builtin_amdgcn_s_setprio(1);
#pragma unroll
            for (int vb = 0; vb < 8; ++vb) { if (resc) { acco[0][vb] = acco[0][vb] * alpha[0]; acco[1][vb] = acco[1][vb] * alpha[1]; }
#pragma unroll
                for (int ks = 0; ks < 2; ++ks) { const bf16x8 vf = tr_frag_a<true>(Vt, vaddr[vb], ks);
                    acco[0][vb] = mfma16(vf, pf[0][ks], acco[0][vb]); acco[1][vb] = mfma16(vf, pf[1][ks], acco[1][vb]); } }
            __builtin_amdgcn_s_setprio(0);
        }
    };
#pragma unroll 1
    for (int j = jst; j < 12; ++j) {
        const int buf = (j - jst) & 1;
        asm volatile("s_waitcnt vmcnt(0)" ::: "memory");
        __syncthreads();
        if (j + 1 < 12) B_DMA(j + 1, buf ^ 1);
        step(j, KV + buf * 32768, KV + buf * 32768 + 16384);
    }
    __syncthreads();
#undef B_DMA
#pragma unroll
    for (int u = 0; u < 2; ++u) {
        float l = lrun[u]; l += __shfl_xor(l, 16); l += __shfl_xor(l, 32);
        const float inv = rcp_f(l);
        const size_t tok = tok0 + 64 * qc + 32 * th + 16 * u + c15;
        const bf16_t* gate = pjp(proj, BG, 128, h, tok);
        bf16_t* y = (bf16_t*)(P.ws + WS_H) + tok * DM + YB + h * 128;
#pragma unroll
        for (int vb = 0; vb < 8; ++vb) { const int v0 = 16 * vb + 4 * g; const u32x2 gt2 = *(const u32x2*)(gate + v0);
            u32x2 o; o.x = cvt_pk_bf16(acco[u][vb][0] * inv * silu_f(bflo(gt2.x)), acco[u][vb][1] * inv * silu_f(bfhi(gt2.x)));
            o.y = cvt_pk_bf16(acco[u][vb][2] * inv * silu_f(bflo(gt2.y)), acco[u][vb][3] * inv * silu_f(bfhi(gt2.y)));
            *(u32x2*)(y + v0) = o; }
    }
}

__device__ __forceinline__ void phase_scan(const Params& P, int tid) {
    const int gt = blockIdx.x * 512 + tid, NT = gridDim.x * 512;
    for (int idx = gt; idx < 49152 + 20480; idx += NT) {
        if (idx < 49152) {
            const int bh = idx >> 12, e = (idx & 4095) * 4, b = bh / 6, h = bh % 6, k = e & 127;
            bf16_t* sp = (bf16_t*)(P.ws + WS_STA) + (size_t)(b * 256 * 6 + h) * 16384 + e;
            const float* dp = (const float*)(P.ws + WS_DEC) + (size_t)(b * 256 * 6 + h) * 128 + k;
            f32x4 S = (f32x4){0.f, 0.f, 0.f, 0.f};
            for (int n0 = 0; n0 < 256; n0 += 16) {
                u32x2 d[16]; f32x4 dc[16];
#pragma unroll
                for (int j = 0; j < 16; ++j) { d[j] = *(const u32x2*)(sp + (size_t)(n0 + j) * (6 * 16384)); dc[j] = *(const f32x4*)(dp + (size_t)(n0 + j) * 768); }
#pragma unroll
                for (int j = 0; j < 16; ++j) { u32x2 o; o.x = cvt_pk_bf16(S[0], S[1]); o.y = cvt_pk_bf16(S[2], S[3]);
                    S[0] = dc[j][0] * S[0] + bflo(d[j].x); S[1] = dc[j][1] * S[1] + bfhi(d[j].x); S[2] = dc[j][2] * S[2] + bflo(d[j].y); S[3] = dc[j][3] * S[3] + bfhi(d[j].y);
                    *(u32x2*)(sp + (size_t)(n0 + j) * (6 * 16384)) = o; }
            }
        } else {
            const int i2 = idx - 49152, bh = i2 >> 11, e = (i2 & 2047) * 4, b = bh / 5, h = bh % 5;
            bf16_t* sp = (bf16_t*)(P.ws + WS_STC) + (size_t)(b * 256 * 5 + h) * 8192 + e;
            const float cd = exp2f(64.f * c_gl2(h));
            f32x4 S = (f32x4){0.f, 0.f, 0.f, 0.f};
            for (int n0 = 0; n0 < 256; n0 += 16) {
                u32x2 d[16];
#pragma unroll
                for (int j = 0; j < 16; ++j) d[j] = *(const u32x2*)(sp + (size_t)(n0 + j) * (5 * 8192));
#pragma unroll
                for (int j = 0; j < 16; ++j) { u32x2 o; o.x = cvt_pk_bf16(S[0], S[1]); o.y = cvt_pk_bf16(S[2], S[3]);
                    S[0] = cd * S[0] + bflo(d[j].x); S[1] = cd * S[1] + bfhi(d[j].x); S[2] = cd * S[2] + bflo(d[j].y); S[3] = cd * S[3] + bfhi(d[j].y);
                    *(u32x2*)(sp + (size_t)(n0 + j) * (5 * 8192)) = o; }
            }
        }
    }
}

#define XB_TMO      128
#define XB_XCNT(j)  (256  + 64 * (j))
#define XB_XSUB(j)  (1280 + 64 * (j))
#define XB_XGEN(j)  (2304 + 64 * (j))
#define XB_TOP      3328
#define XB_TOPGEN   3392
#define XCD_BAR_WORDS 3456
#define XB_SPIN_CAP (1u << 18)

__device__ __forceinline__ unsigned xb_ld(unsigned* p)              { return __hip_atomic_load(p, __ATOMIC_RELAXED, __HIP_MEMORY_SCOPE_AGENT); }
__device__ __forceinline__ unsigned xb_add(unsigned* p, unsigned v) { return __hip_atomic_fetch_add(p, v, __ATOMIC_RELAXED, __HIP_MEMORY_SCOPE_AGENT); }
__device__ __forceinline__ unsigned xb_xcc_id() { return (unsigned)__builtin_amdgcn_s_getreg((3 << 11) | 20) & 0xFu; }
#define XB_SPIN(cond, bar) do { unsigned _sp = 0; while (cond) { __builtin_amdgcn_s_sleep(1); \
    if ((++_sp & 255u) == 0u) { if (xb_ld(&(bar)[XB_TMO])) break; if (_sp > XB_SPIN_CAP) { atomicAdd(&(bar)[XB_TMO], 1u); break; } } } } while (0)

struct XcdBarrier {
    unsigned* bar; unsigned x;
    volatile LAS unsigned* st;
};

__device__ __forceinline__ XcdBarrier xcd_barrier_post(unsigned* bar, volatile LAS unsigned* st) {
    XcdBarrier b; b.bar = bar; b.x = xb_xcc_id(); b.st = st;
    if (threadIdx.x == 0) (void)xb_add(&bar[XB_XCNT(b.x)], 1u);
    return b;
}
__device__ __forceinline__ void xcd_barrier_complete(unsigned* bar, unsigned x, unsigned& nloc, unsigned& nx) {
    const unsigned G = gridDim.x * gridDim.y * gridDim.z;
    unsigned sum, cnt, mine, sp = 0u;
    for (;;) {
        sum = 0u; cnt = 0u; mine = 0u;
#pragma unroll
        for (unsigned j = 0; j < 16; ++j) { const unsigned c = xb_ld(&bar[XB_XCNT(j)]); sum += c; cnt += (c > 0u) ? 1u : 0u; mine = (j == x) ? c : mine; }
        if (sum == G) break;
        __builtin_amdgcn_s_sleep(1);
        if ((++sp & 255u) == 0u) { if (xb_ld(&bar[XB_TMO])) break; if (sp > XB_SPIN_CAP) { atomicAdd(&bar[XB_TMO], 1u); break; } }
    }
    nloc = mine > 0u ? mine : 1u; nx = cnt > 0u ? cnt : 1u;
}

__device__ __forceinline__ void xcd_barrier(const XcdBarrier& b) {
    asm volatile("s_waitcnt vmcnt(0)" ::: "memory");
    __syncthreads();
    if (threadIdx.x == 0) {
        unsigned* bar = b.bar;
        __builtin_amdgcn_s_waitcnt(0);
        unsigned nloc = b.st[0], nx = b.st[1];
        if (nloc == 0u) { xcd_barrier_complete(bar, b.x, nloc, nx); b.st[0] = nloc; b.st[1] = nx; }
        const unsigned old = xb_add(&bar[XB_XSUB(b.x)], 1u);
        const unsigned gen = old / nloc;
        if (old + 1u == (gen + 1u) * nloc) {
            __builtin_amdgcn_fence(__ATOMIC_RELEASE, "agent");
            asm volatile("s_waitcnt vmcnt(0)" ::: "memory");
            const unsigned og = xb_add(&bar[XB_TOP], 1u);
            const unsigned tg = og / nx;
            if (og + 1u == (tg + 1u) * nx) xb_add(&bar[XB_TOPGEN], 1u);
            else XB_SPIN(xb_ld(&bar[XB_TOPGEN]) == tg, bar);
            __builtin_amdgcn_fence(__ATOMIC_ACQUIRE, "agent");
            xb_add(&bar[XB_XGEN(b.x)], 1u);
            asm volatile("s_waitcnt vmcnt(0)" ::: "memory");
        } else {
            XB_SPIN(xb_ld(&bar[XB_XGEN(b.x)]) == gen, bar);
            __builtin_amdgcn_fence(__ATOMIC_ACQUIRE, "agent");
            asm volatile("s_waitcnt vmcnt(0)" ::: "memory");
        }
    }
    __syncthreads();
}

__global__ __launch_bounds__(512, 2) void hybrid_fwd(Params P0) {
    extern __shared__ __attribute__((aligned(16))) unsigned char shm[];
    LAS unsigned char* lds = (LAS unsigned char*)shm;
    cg::grid_group grid = cg::this_grid();
    volatile LAS unsigned* xst = (volatile LAS unsigned*)(lds + 139248);
    if (threadIdx.x == 0) { xst[0] = 0u; xst[1] = 0u; }
    __syncthreads();
    XcdBarrier xb = xcd_barrier_post((unsigned*)(P0.ws + WS_END), xst);
    for (int ph = P0.ph_lo; ph < P0.ph_hi; ++ph) {
        if (ph > P0.ph_lo) { if (P0.ph_lo < 0) grid.sync();   xcd_barrier(xb); }
        Params P = P0; int tid = threadIdx.x;
        { size_t z0 = 0, z1 = 0, z2 = 0; asm volatile("" : "+s"(z0), "+s"(z1), "+s"(z2), "+v"(tid));
          P.ws = P0.ws + z0; P.out = P0.out + z1; P.x = P0.x + z2; P.w_in = P0.w_in + z0; P.norm_gain = P0.norm_gain + z1; P.lb_logits = P0.lb_logits + z2;
          P.hg_gain = P0.hg_gain + z0; P.rel_bias = P0.rel_bias + z1; P.w_out = P0.w_out + z2; P.final_gain = P0.final_gain + z0; }
        if (ph == 0) { phase_prep(P, lds, tid); continue; }
        const int layer = (ph - 1) / 6, sub = (ph - 1) % 6;
        {
        if (sub == 0) {
            pg8::Gemm gm{(const bf16_t*)(P.ws + WS_H), (const bf16_t*)(P.ws + WS_WIN) + (size_t)layer * LDP * DM, NTOK, LDP, DM};
            pg8::StaticOrder S; S.init(NTOK, LDP, (int)gridDim.x, (int)blockIdx.x);
            pg8::EpiProj E{(bf16_t*)(P.ws + WS_PROJ)};
            pg8::gemm_phase(lds, gm, S, E);
        } else if (sub == 1) {
            a1_phase(P, layer, lds, tid);
            c1_phase(P, lds, tid);
        } else if (sub == 2) {
            phase_scan(P, tid);
            {
                unsigned* ctr = (unsigned*)(P.ws + WS_END) + 3584 + layer; LAS int* sit = (LAS int*)(lds + 132608);
                for (;;) {
                    if (tid == 0) *sit = (int)atomicAdd(ctr, 1u);
                    __syncthreads();
                    const int it = *sit;
                    __syncthreads();
                    if (it >= 640) break;
                    b_item(P, layer, lds, it, tid);
                }
            }
        } else if (sub == 3) {
            a3_phase(P, layer, lds, tid); __syncthreads();
            c3_phase(P, lds, tid);
        } else if (sub == 4) {
            pg8::Gemm gm{(const bf16_t*)(P.ws + WS_H), (const bf16_t*)(P.ws + WS_WOUT) + (size_t)layer * DM * DM, NTOK, DM, DM};
            pg8::StaticOrder S; S.init(NTOK, DM, (int)gridDim.x, (int)blockIdx.x);
            pg8::EpiBf16 E{(bf16_t*)(P.ws + (layer == 0 ? WS_D1 : WS_PROJ)), DM};
            pg8::gemm_phase(lds, gm, S, E);
        } else {
            if (layer == 0) phase_norm<false>(P.x, (const bf16_t*)(P.ws + WS_D1), nullptr, P.norm_gain + DM, (bf16_t*)(P.ws + WS_H), nullptr, tid, (bf16_t*)(P.ws + WS_D1));
            else phase_final((const bf16_t*)(P.ws + WS_D1), (const bf16_t*)(P.ws + WS_PROJ), P.final_gain, P.out, tid);
        }
        }
    }
}

constexpr int NPHASES = 13;
constexpr int LDS_BYTES = 131072 + 8192;

extern "C" void kernel_launch(void* const* d_in, const int* in_sizes, int n_in, void* d_out, int out_size, void* d_ws, size_t ws_size, hipStream_t stream) {
    static int grid = 0;
    if (grid == 0) {
        if (n_in != 8 || ws_size < WS_TOTAL) { fprintf(stderr, "kernel_launch: unexpected inputs (n_in %d, ws %zu < %zu)\n", n_in, ws_size, (size_t)WS_END); grid = -1; return; }
        if (hipFuncSetAttribute((const void*)hybrid_fwd, hipFuncAttributeMaxDynamicSharedMemorySize, LDS_BYTES) != hipSuccess) { fprintf(stderr, "hipFuncSetAttribute failed\n"); grid = -1; return; }
        int dev = 0, cus = 0, per_cu = 0;
        (void)hipGetDevice(&dev); (void)hipDeviceGetAttribute(&cus, hipDeviceAttributeMultiprocessorCount, dev);
        (void)hipOccupancyMaxActiveBlocksPerMultiprocessor(&per_cu, (const void*)hybrid_fwd, 512, LDS_BYTES);
        if (per_cu < 1) { fprintf(stderr, "occupancy query says 0 blocks per CU\n"); per_cu = 1; }
        (void)hipGetLastError();
        grid = cus;
    }
    if (grid < 0) return;
    Params p{};
    p.x = (const float*)d_in[0]; p.w_in = (const float*)d_in[1]; p.norm_gain = (const float*)d_in[2]; p.lb_logits = (const float*)d_in[3];
    p.hg_gain = (const float*)d_in[4]; p.rel_bias = (const float*)d_in[5]; p.w_out = (const float*)d_in[6]; p.final_gain = (const float*)d_in[7];
    p.out = (float*)d_out; p.ws = (unsigned char*)d_ws;
    if (hipMemsetAsync((unsigned char*)d_ws + WS_END, 0, WS_BARB, stream) != hipSuccess) { fprintf(stderr, "memset of the barrier words failed\n"); return; }
    p.ph_lo = 0; p.ph_hi = NPHASES;
    void* args[] = {&p};
    hipError_t e = hipLaunchCooperativeKernel((const void*)hybrid_fwd, dim3(grid), dim3(512), args, LDS_BYTES, stream);
    if (e != hipSuccess) fprintf(stderr, "cooperative launch failed: %s (grid %d)\n", hipGetErrorString(e), grid);
}
```

```cpp
#include <hip/hip_runtime.h>
#include <hip/hip_cooperative_groups.h>
#include <cstdio>
namespace cg = cooperative_groups;

#define LAS __attribute__((address_space(3)))
typedef unsigned short bf16_t;
typedef short bf16x8 __attribute__((ext_vector_type(8)));
typedef short s16x4 __attribute__((ext_vector_type(4)));
typedef float f32x4 __attribute__((ext_vector_type(4)));
typedef float f32x2 __attribute__((ext_vector_type(2)));
typedef unsigned u32x4 __attribute__((ext_vector_type(4)));
typedef unsigned u32x2 __attribute__((ext_vector_type(2)));

constexpr int NTOK = 32768, SEQ = 16384, DM = 2048, NCHB = 256  , NCH = 512;
constexpr int LDP = 7680;
constexpr int DIN = 7552;
constexpr int AQ = 0, AF = 768, AI = 1536, AG = 2304, BQ = 3072, BKC = 3712, BV = 4352, BG = 4992, CQ = 5632, CK = 5952, CV = 6272, CG = 6912;
constexpr int YA = 0, YB = 768, YC = 1408;
constexpr float EPSN = 1e-6f;

constexpr size_t WS_WIN = 0;
constexpr size_t WS_WOUT = WS_WIN + (size_t)2 * LDP * DM * 2;
constexpr size_t WS_H = WS_WOUT + (size_t)2 * DM * DM * 2;
constexpr size_t WS_PROJ = WS_H + (size_t)NTOK * DM * 2;
constexpr size_t WS_STA = WS_PROJ + (size_t)NTOK * LDP * 2;
constexpr size_t WS_STC = WS_STA + (size_t)NCH * 6 * 128 * 128 * 2;
constexpr size_t WS_DEC = WS_STC + (size_t)NCH * 5 * 128 * 64 * 2;
constexpr size_t WS_CS = WS_DEC + (size_t)NCH * 6 * 128 * 4;
constexpr size_t WS_END = WS_CS + (size_t)SEQ * 32 * 8;
constexpr size_t WS_BARB = 16384;
constexpr size_t WS_D1 = WS_END + WS_BARB;
constexpr size_t WS_TOTAL = WS_D1 + (size_t)NTOK * DM * 2;

struct Params {
    const float *x, *w_in, *norm_gain, *lb_logits, *hg_gain, *rel_bias, *w_out, *final_gain;
    float* out; unsigned char* ws;
    int ph_lo, ph_hi;
};

__device__ __forceinline__ const bf16_t* pjp(const bf16_t* proj, int tcol, int W, int h, size_t tok) { return proj + (size_t)tcol * NTOK + ((size_t)h * NTOK + tok) * W; }
typedef __bf16 bf16x2_t __attribute__((ext_vector_type(2)));
__device__ __forceinline__ unsigned cvt_pk_bf16(float lo, float hi) { const f32x2 f = {lo, hi}; const bf16x2_t v = __builtin_convertvector(f, bf16x2_t); return __builtin_bit_cast(unsigned, v); }
__device__ __forceinline__ bf16_t f2bf(float v) { return (bf16_t)(cvt_pk_bf16(v, 0.f) & 0xffffu); }
__device__ __forceinline__ float bf2f(bf16_t u) { return __uint_as_float((unsigned)u << 16); }
__device__ __forceinline__ float bflo(unsigned u) { return __uint_as_float(u << 16); }
__device__ __forceinline__ float bfhi(unsigned u) { return __uint_as_float(u & 0xffff0000u); }
__device__ __forceinline__ float wave_sum(float v) {
#pragma unroll
    for (int o = 1; o < 64; o <<= 1) v += __shfl_xor(v, o);
    return v;
}
__device__ __forceinline__ float rcp_f(float v) { return __builtin_amdgcn_rcpf(v); }
__device__ __forceinline__ float silu_f(float v) { return v * rcp_f(1.f + __expf(-v)); }

__device__ __forceinline__ unsigned off_b(unsigned row, unsigned ch) { return 256u * row + 16u * (ch ^ (((row & 3u) << 2) | ((row >> 2) & 3u))); }
__device__ __forceinline__ bf16x8 row_frag(LAS unsigned char* tile, int rb, int s, int lane) {
    return *(const LAS bf16x8*)(tile + off_b((unsigned)((lane & 15) + 16 * rb), (unsigned)(4 * s + (lane >> 4))));
}
template <bool PERM>
__device__ __forceinline__ bf16x8 tr_frag(LAS unsigned char* tile, int c, int ks, int lane) {
    const unsigned g = lane >> 4, q = (lane & 15) >> 2, p = lane & 3;
    const unsigned r0 = 32u * ks + (PERM ? 4u * g : 8u * g) + q, r1 = r0 + (PERM ? 16u : 4u);
    const unsigned ch = 2u * c + (p >> 1), sub = 8u * (p & 1);
    const s16x4 a = __builtin_amdgcn_ds_read_tr16_b64_v4i16((LAS s16x4*)(tile + off_b(r0, ch) + sub));
    const s16x4 b = __builtin_amdgcn_ds_read_tr16_b64_v4i16((LAS s16x4*)(tile + off_b(r1, ch) + sub));
    bf16x8 r; r[0] = a[0]; r[1] = a[1]; r[2] = a[2]; r[3] = a[3]; r[4] = b[0]; r[5] = b[1]; r[6] = b[2]; r[7] = b[3]; return r;
}
__device__ __forceinline__ unsigned row_addr(int lane, int s) { return off_b((unsigned)(lane & 15), (unsigned)(4 * s + (lane >> 4))); }
__device__ __forceinline__ bf16x8 row_frag_a(LAS unsigned char* tile, unsigned addr, int rb) { return *(const LAS bf16x8*)(tile + addr + 4096 * rb); }
template <bool PERM>
__device__ __forceinline__ unsigned tr_addr(int lane, int c) { const unsigned g = lane >> 4, q = (lane & 15) >> 2, p = lane & 3;
    return off_b((PERM ? 4u * g : 8u * g) + q, 2u * c + (p >> 1)) + 8u * (p & 1); }
__device__ __forceinline__ unsigned tr_addr_n1(int lane, int c) { const unsigned g = lane >> 4, q = (lane & 15) >> 2, p = lane & 3;
    return off_b(8u * g + 4u + q, 2u * c + (p >> 1)) + 8u * (p & 1); }
__device__ __forceinline__ bf16x8 tr_frag_n(LAS unsigned char* tile, unsigned addr0, unsigned addr1, int ks) {
    const s16x4 a = __builtin_amdgcn_ds_read_tr16_b64_v4i16((LAS s16x4*)(tile + addr0 + 8192 * ks));
    const s16x4 b = __builtin_amdgcn_ds_read_tr16_b64_v4i16((LAS s16x4*)(tile + addr1 + 8192 * ks));
    bf16x8 r; r[0] = a[0]; r[1] = a[1]; r[2] = a[2]; r[3] = a[3]; r[4] = b[0]; r[5] = b[1]; r[6] = b[2]; r[7] = b[3]; return r;
}
template <bool PERM>
__device__ __forceinline__ bf16x8 tr_frag_a(LAS unsigned char* tile, unsigned addr, int ks) {
    static_assert(PERM, "natural order: use tr_frag_n");
    const s16x4 a = __builtin_amdgcn_ds_read_tr16_b64_v4i16((LAS s16x4*)(tile + addr + 8192 * ks));
    const s16x4 b = __builtin_amdgcn_ds_read_tr16_b64_v4i16((LAS s16x4*)(tile + addr + 8192 * ks + (PERM ? 4096 : 1024)));
    bf16x8 r; r[0] = a[0]; r[1] = a[1]; r[2] = a[2]; r[3] = a[3]; r[4] = b[0]; r[5] = b[1]; r[6] = b[2]; r[7] = b[3]; return r;
}
__device__ __forceinline__ f32x4 mfma16(bf16x8 a, bf16x8 b, f32x4 c) { return __builtin_amdgcn_mfma_f32_16x16x32_bf16(a, b, c, 0, 0, 0); }
__device__ __forceinline__ void lds_put(LAS unsigned char* tile, int row, int col, float v) { *(LAS bf16_t*)(tile + off_b((unsigned)row, (unsigned)(col >> 3)) + 2 * (col & 7)) = f2bf(v); }
template <int ROWS, int CH>
__device__ __forceinline__ void tile_load(LAS unsigned char* tile, const bf16_t* src, int ld, int tid) {
#pragma unroll
    for (int u = 0; u < ROWS * CH / 512; ++u) { const int i = tid + 512 * u, row = i / CH, ch = i % CH;
        *(LAS u32x4*)(tile + off_b((unsigned)row, (unsigned)ch)) = *(const u32x4*)(src + (size_t)row * ld + ch * 8); }
}
__device__ __forceinline__ bf16x8 pack8(f32x4 a, f32x4 b) {
    u32x4 w; w.x = cvt_pk_bf16(a[0], a[1]); w.y = cvt_pk_bf16(a[2], a[3]); w.z = cvt_pk_bf16(b[0], b[1]); w.w = cvt_pk_bf16(b[2], b[3]);
    return __builtin_bit_cast(bf16x8, w);
}

namespace pg8 {
constexpr int BM = 256, BK = 64, HALF = 128, HTB = HALF * BK * 2, STAGE_BYTES = 8 * HTB, NXCD = 8, WGM = 8;
__device__ __forceinline__ int lds_byte(int r, int c) { const int st = (r >> 4) * 2 + (c >> 5), rr = r & 15, cc = c & 31, ob = rr * 64 + cc * 2; return st * 1024 + (ob ^ (((ob >> 9) & 1) << 5)); }
__device__ __forceinline__ void stage_rc(int b, int& R, int& C) { const int st = b / 1024, sb = b % 1024, swz = sb ^ (((sb >> 9) & 1) << 5); R = (st >> 1) * 16 + swz / 64; C = (st & 1) * 32 + (swz % 64) / 2; }
__device__ __forceinline__ int perm32(int rho) { const int n = rho >> 4, i = rho & 15; return 8 * (i >> 2) + 4 * n + (i & 3); }
struct Unit { int pm, pn; };
struct Gemm { const bf16_t* A; const bf16_t* Bt; int M, N, K; };
struct StaticOrder {
    int nM, nN, nwg, G, c;
    __device__ void init(int M, int N, int G_, int c_) { nM = M / BM; nN = N / BM; nwg = nM * nN; G = G_; c = c_; }
    __device__ bool next(int i, Unit& u) const {
        const long L = (long)i * G + c; if (L >= nwg) return false;
        int wgid = (int)L; { const int q = nwg / NXCD, r = nwg % NXCD, xcd = wgid % NXCD, off = wgid / NXCD; wgid = (xcd < r ? xcd * (q + 1) : r * (q + 1) + (xcd - r) * q) + off; }
        const int nig = WGM * nN, gid = wgid / nig, fm = gid * WGM, gsz = (nM - fm) < WGM ? (nM - fm) : WGM;
        u.pm = fm + ((wgid % nig) % gsz); u.pn = (wgid % nig) / gsz; return true;
    }
    __device__ __forceinline__ void a_ready(const Unit&) const {}
    __device__ __forceinline__ void done(const Unit&) const {}
};
struct EpiBf16 {
    static constexpr bool PERM = true;
    bf16_t* O; int ldc;
    __device__ __forceinline__ void operator()(const f32x4 (&acc)[2][2][4][2], const Unit& u, int wr, int wc, int fr, int fq) const {
        const int row0 = u.pm * BM + wr * 64 + fr; const int col0 = u.pn * BM + wc * 32 + 8 * fq;
#pragma unroll
        for (int ai = 0; ai < 2; ++ai)
#pragma unroll
            for (int m = 0; m < 4; ++m) { bf16_t* rowp = O + (size_t)(row0 + ai * HALF + m * 16) * ldc + col0;
#pragma unroll
                for (int bj = 0; bj < 2; ++bj) { const f32x4 v0 = acc[ai][bj][m][0], v1 = acc[ai][bj][m][1];
                    u32x4 w; w.x = cvt_pk_bf16(v0[0], v0[1]); w.y = cvt_pk_bf16(v0[2], v0[3]); w.z = cvt_pk_bf16(v1[0], v1[1]); w.w = cvt_pk_bf16(v1[2], v1[3]);
                    *(u32x4*)(rowp + bj * HALF) = w; } }
    }
};

struct EpiProj {
    static constexpr bool PERM = true;
    bf16_t* O;
    __device__ __forceinline__ void operator()(const f32x4 (&acc)[2][2][4][2], const Unit& u, int wr, int wc, int fr, int fq) const {
        const int row0 = u.pm * BM + wr * 64 + fr;
#pragma unroll
        for (int bj = 0; bj < 2; ++bj) { const int c32 = u.pn * BM + bj * HALF + wc * 32;
            if (c32 >= DIN) continue;
            int ts, W = 128;
            if (c32 < AF) ts = AQ; else if (c32 < AI) ts = AF; else if (c32 < AG) ts = AI; else if (c32 < BQ) ts = AG; else if (c32 < BKC) ts = BQ; else if (c32 < BV) ts = BKC;
            else if (c32 < BG) ts = BV; else if (c32 < CQ) ts = BG; else if (c32 < CK) { ts = CQ; W = 64; } else if (c32 < CV) { ts = CK; W = 64; } else if (c32 < CG) ts = CV; else ts = CG;
            const int cp = c32 - ts, h = cp / W, d = cp % W + 8 * fq;
            bf16_t* base = O + (size_t)ts * NTOK + (size_t)h * NTOK * W + d;
#pragma unroll
            for (int ai = 0; ai < 2; ++ai)
#pragma unroll
                for (int m = 0; m < 4; ++m) { const f32x4 v0 = acc[ai][bj][m][0], v1 = acc[ai][bj][m][1];
                    u32x4 w; w.x = cvt_pk_bf16(v0[0], v0[1]); w.y = cvt_pk_bf16(v0[2], v0[3]); w.z = cvt_pk_bf16(v1[0], v1[1]); w.w = cvt_pk_bf16(v1[2], v1[3]);
                    *(u32x4*)(base + (size_t)(row0 + ai * HALF + m * 16) * W) = w; } }
    }
};

template <class Epi, class Sched>
__device__ __forceinline__ void gemm_phase(LAS unsigned char* lds, const Gemm g, const Sched& S, const Epi& E) {
    const int tid = threadIdx.x, wid = __builtin_amdgcn_readfirstlane(tid >> 6), lane = tid & 63, wr = wid >> 2, wc = wid & 3, fr = lane & 15, fq = lane >> 4;
    const int K = g.K, nt = K / BK;
    unsigned voffA[2], voffB[2];
#pragma unroll
    for (int i = 0; i < 2; ++i) { int R, C; stage_rc(tid * 16 + i * 8192, R, C); const int Rb = Epi::PERM ? ((R & ~31) + perm32(R & 31)) : R;
        voffA[i] = (unsigned)(R * K + C) * 2u; voffB[i] = (unsigned)(Rb * K + C) * 2u; }
    const size_t kstep = (size_t)(BK * 2);
    const size_t hstep = (size_t)HALF * K * 2;
    const size_t tstep = 2 * hstep;
    const unsigned ldsw = (unsigned)wid * 1024u;
    const int aoff = lds_byte(wr * 64 + fr, fq * 8), boff = lds_byte(wc * 32 + fr, fq * 8);
#define PG8_SA(b, h) (((b) * 2 + (h)) * HTB)
#define PG8_SB(b, h) ((4 + (b) * 2 + (h)) * HTB)
#define PG8_STAGE(bufoff, gbase, voff) do { _Pragma("unroll") for (int _i = 0; _i < 2; ++_i) \
        __builtin_amdgcn_global_load_lds((const unsigned*)((const char*)(gbase) + (voff)[_i]), (LAS unsigned*)(lds + (bufoff) + ldsw + _i * 8192), 16, 0, 0); } while (0)
#define PG8_LDA(dst, b, h) do { _Pragma("unroll") for (int m = 0; m < 4; ++m) _Pragma("unroll") for (int k = 0; k < 2; ++k) dst[m][k] = *(const LAS bf16x8*)(lds + PG8_SA(b, h) + aoff + m * 2048 + k * 1024); } while (0)
#define PG8_LDB(dst, b, h) do { _Pragma("unroll") for (int n = 0; n < 2; ++n) _Pragma("unroll") for (int k = 0; k < 2; ++k) dst[n][k] = *(const LAS bf16x8*)(lds + PG8_SB(b, h) + boff + n * 2048 + k * 1024); } while (0)
#define PG8_MMA(ai, bj, At, Bt) do { __builtin_amdgcn_s_setprio(1); _Pragma("unroll") for (int m = 0; m < 4; ++m) _Pragma("unroll") for (int n = 0; n < 2; ++n) _Pragma("unroll") for (int k = 0; k < 2; ++k) \
        acc[ai][bj][m][n] = __builtin_amdgcn_mfma_f32_16x16x32_bf16(Bt[n][k], At[m][k], acc[ai][bj][m][n], 0, 0, 0); __builtin_amdgcn_s_setprio(0); } while (0)
#define PG8_WAIT_V(n) asm volatile("s_waitcnt vmcnt(" #n ")" ::: "memory")
#define PG8_WAIT_L(n) asm volatile("s_waitcnt lgkmcnt(" #n ")" ::: "memory")
#define PG8_BAR __builtin_amdgcn_s_barrier()
#define PG8_SCHED __builtin_amdgcn_sched_barrier(0)
    Unit cur, nxt; int ui = 0;
    if (!S.next(0, cur)) return;
    f32x4 acc[2][2][4][2];
#pragma unroll
    for (int a = 0; a < 2; ++a)
#pragma unroll
        for (int b = 0; b < 2; ++b)
#pragma unroll
            for (int m = 0; m < 4; ++m)
#pragma unroll
                for (int n = 0; n < 2; ++n) acc[a][b][m][n] = (f32x4){0.f, 0.f, 0.f, 0.f};
    bf16x8 At[4][2], B0[2][2], B1[2][2];
    const char* cA = (const char*)g.A + (size_t)cur.pm * tstep; const char* cB = (const char*)g.Bt + (size_t)cur.pn * tstep;
    S.a_ready(cur);
    PG8_STAGE(PG8_SB(0, 0), cB, voffB); PG8_STAGE(PG8_SA(0, 0), cA, voffA); PG8_STAGE(PG8_SB(0, 1), cB + hstep, voffB); PG8_STAGE(PG8_SA(0, 1), cA + hstep, voffA);
    if (wr == 1) PG8_BAR;
    PG8_WAIT_V(4); PG8_BAR;
    PG8_STAGE(PG8_SB(1, 0), cB + kstep, voffB); PG8_STAGE(PG8_SA(1, 0), cA + kstep, voffA); PG8_STAGE(PG8_SB(1, 1), cB + hstep + kstep, voffB);
    PG8_WAIT_V(6); PG8_BAR;
    for (;;) {
        const bool has_next = S.next(ui + 1, nxt);
        const char* nA = has_next ? (const char*)g.A + (size_t)nxt.pm * tstep : cA; const char* nB = has_next ? (const char*)g.Bt + (size_t)nxt.pn * tstep : cB;
        for (int t = 0; t < nt; t += 2) {
            const bool last = (t == nt - 2);
            const char* a1 = cA + (size_t)(t + 1) * kstep;
            const char* a2 = last ? nA : cA + (size_t)(t + 2) * kstep; const char* b2 = last ? nB : cB + (size_t)(t + 2) * kstep;
            const char* a3 = a2 + kstep; const char* b3 = b2 + kstep;
            if (last && has_next) S.a_ready(nxt);
            PG8_LDB(B0, 0, 0); PG8_SCHED; PG8_LDA(At, 0, 0); PG8_STAGE(PG8_SA(1, 1), a1 + hstep, voffA);
            PG8_WAIT_L(8); PG8_BAR; PG8_WAIT_L(0); PG8_MMA(0, 0, At, B0); PG8_BAR; PG8_SCHED;
            PG8_LDB(B1, 0, 1); PG8_STAGE(PG8_SB(0, 0), b2, voffB);
            PG8_BAR; PG8_WAIT_L(0); PG8_MMA(0, 1, At, B1); PG8_BAR;
            PG8_LDA(At, 0, 1); PG8_STAGE(PG8_SA(0, 0), a2, voffA);
            PG8_BAR; PG8_WAIT_L(0); PG8_MMA(1, 0, At, B0); PG8_BAR; PG8_SCHED;
            PG8_STAGE(PG8_SB(0, 1), b2 + hstep, voffB);
            PG8_WAIT_V(6); PG8_BAR; PG8_MMA(1, 1, At, B1); PG8_BAR;
            PG8_LDB(B0, 1, 0); PG8_SCHED; PG8_LDA(At, 1, 0); PG8_STAGE(PG8_SA(0, 1), a2 + hstep, voffA);
            PG8_WAIT_L(8); PG8_BAR; PG8_WAIT_L(0); PG8_MMA(0, 0, At, B0); PG8_BAR; PG8_SCHED;
            PG8_LDB(B1, 1, 1); PG8_STAGE(PG8_SB(1, 0), b3, voffB);
            PG8_BAR; PG8_WAIT_L(0); PG8_MMA(0, 1, At, B1); PG8_BAR;
            PG8_LDA(At, 1, 1); PG8_STAGE(PG8_SA(1, 0), a3, voffA);
            PG8_BAR; PG8_WAIT_L(0); PG8_MMA(1, 0, At, B0); PG8_BAR; PG8_SCHED;
            PG8_STAGE(PG8_SB(1, 1), b3 + hstep, voffB);
            PG8_WAIT_V(6); PG8_BAR; PG8_MMA(1, 1, At, B1); PG8_BAR;
        }
        E(acc, cur, wr, wc, fr, fq); S.done(cur);
        if (!has_next) break;
#pragma unroll
        for (int a = 0; a < 2; ++a)
#pragma unroll
            for (int b = 0; b < 2; ++b)
#pragma unroll
                for (int m = 0; m < 4; ++m)
#pragma unroll
                    for (int n = 0; n < 2; ++n) acc[a][b][m][n] = (f32x4){0.f, 0.f, 0.f, 0.f};
        cur = nxt; cA = nA; cB = nB; ++ui;
    }
    PG8_WAIT_V(0);
    if (wr == 0) PG8_BAR;
    PG8_BAR;
#undef PG8_SA
#undef PG8_SB
#undef PG8_STAGE
#undef PG8_LDA
#undef PG8_LDB
#undef PG8_MMA
#undef PG8_WAIT_V
#undef PG8_WAIT_L
#undef PG8_BAR
#undef PG8_SCHED
}
}

#define LDS_WAIT() asm volatile("s_waitcnt lgkmcnt(0)" ::: "memory")
__device__ __forceinline__ void p0_transpose_item(const float* W, int K, int N, bf16_t* WT, LAS float* scr, int item, int lane, bool stream = false) {
    const int nblk = N / 32, kb = item / nblk, nb = item % nblk, k0 = 64 * kb, n0 = 32 * nb;
#pragma unroll 8
    for (int i = 0; i < 32; ++i) { const int kk = 2 * i + (lane >> 5); scr[kk * 33 + (lane & 31)] = W[(size_t)(k0 + kk) * N + n0 + (lane & 31)]; }
    LDS_WAIT(); asm volatile("" ::: "memory");
    const int c = lane & 7;
#pragma unroll
    for (int j = 0; j < 4; ++j) { const int n = (lane >> 3) + 8 * j; const LAS float* s = scr + (8 * c) * 33 + n;
        u32x4 o; o.x = cvt_pk_bf16(s[0 * 33], s[1 * 33]); o.y = cvt_pk_bf16(s[2 * 33], s[3 * 33]); o.z = cvt_pk_bf16(s[4 * 33], s[5 * 33]); o.w = cvt_pk_bf16(s[6 * 33], s[7 * 33]);
        if (stream) __builtin_nontemporal_store(o, (u32x4*)(WT + (size_t)(n0 + n) * K + k0 + 8 * c)); else *(u32x4*)(WT + (size_t)(n0 + n) * K + k0 + 8 * c) = o; }
    LDS_WAIT(); asm volatile("" ::: "memory");
}
template <bool FINAL>
__device__ __forceinline__ void norm_row(int row, const float* src, const bf16_t* d1, const bf16_t* d2, const f32x4 (&gv)[8], bf16_t* dsth, float* dstf, int lane, bf16_t* xb = nullptr) {
    const float* xr = src + (size_t)row * DM;
    f32x4 v[8]; float ss = 0.f;
#pragma unroll
    for (int j = 0; j < 8; ++j) v[j] = *(const f32x4*)(xr + 4 * (lane + 64 * j));
    if (d1) {
#pragma unroll
        for (int j = 0; j < 8; ++j) { const u32x2 a = *(const u32x2*)(d1 + (size_t)row * DM + 4 * (lane + 64 * j));
            v[j][0] += bflo(a.x); v[j][1] += bfhi(a.x); v[j][2] += bflo(a.y); v[j][3] += bfhi(a.y); } }
    if (d2) {
#pragma unroll
        for (int j = 0; j < 8; ++j) { const u32x2 a = *(const u32x2*)(d2 + (size_t)row * DM + 4 * (lane + 64 * j));
            v[j][0] += bflo(a.x); v[j][1] += bfhi(a.x); v[j][2] += bflo(a.y); v[j][3] += bfhi(a.y); } }
    if (xb) {
#pragma unroll
        for (int j = 0; j < 8; ++j) { u32x2 w; w.x = cvt_pk_bf16(v[j][0], v[j][1]); w.y = cvt_pk_bf16(v[j][2], v[j][3]); *(u32x2*)(xb + (size_t)row * DM + 4 * (lane + 64 * j)) = w; } }
#pragma unroll
    for (int j = 0; j < 8; ++j) ss += (v[j][0] * v[j][0] + v[j][1] * v[j][1]) + (v[j][2] * v[j][2] + v[j][3] * v[j][3]);
    const float r = rsqrtf(wave_sum(ss) * (1.f / DM) + EPSN);
#pragma unroll
    for (int j = 0; j < 8; ++j) { const f32x4 o = v[j] * r * gv[j];
        if (FINAL) __builtin_nontemporal_store(o, (f32x4*)(dstf + (size_t)row * DM + 4 * (lane + 64 * j)));
        else { u32x2 w; w.x = cvt_pk_bf16(o[0], o[1]); w.y = cvt_pk_bf16(o[2], o[3]); *(u32x2*)(dsth + (size_t)row * DM + 4 * (lane + 64 * j)) = w; } }
}
__device__ __forceinline__ void phase_final(const bf16_t* a, const bf16_t* b, const float* gain, float* dst, int tid) {
    const int wave = tid >> 6, lane = tid & 63;
    f32x4 gv[8];
#pragma unroll
    for (int j = 0; j < 8; ++j) gv[j] = *(const f32x4*)(gain + 4 * (lane + 64 * j));
    for (int row = blockIdx.x * 8 + wave; row < NTOK; row += gridDim.x * 8) {
        f32x4 v[8]; float ss = 0.f;
#pragma unroll
        for (int j = 0; j < 8; ++j) { const u32x2 p = *(const u32x2*)(a + (size_t)row * DM + 4 * (lane + 64 * j)), q = *(const u32x2*)(b + (size_t)row * DM + 4 * (lane + 64 * j));
            v[j][0] = bflo(p.x) + bflo(q.x); v[j][1] = bfhi(p.x) + bfhi(q.x); v[j][2] = bflo(p.y) + bflo(q.y); v[j][3] = bfhi(p.y) + bfhi(q.y);
            ss += (v[j][0] * v[j][0] + v[j][1] * v[j][1]) + (v[j][2] * v[j][2] + v[j][3] * v[j][3]); }
        const float r = rsqrtf(wave_sum(ss) * (1.f / DM) + EPSN);
#pragma unroll
        for (int j = 0; j < 8; ++j) __builtin_nontemporal_store(v[j] * r * gv[j], (f32x4*)(dst + (size_t)row * DM + 4 * (lane + 64 * j)));
    }
}
template <bool FINAL>
__device__ __forceinline__ void phase_norm(const float* src, const bf16_t* d1, const bf16_t* d2, const float* gain, bf16_t* dsth, float* dstf, int tid, bf16_t* xb = nullptr) {
    const int wave = tid >> 6, lane = tid & 63;
    f32x4 gv[8];
#pragma unroll
    for (int j = 0; j < 8; ++j) gv[j] = *(const f32x4*)(gain + 4 * (lane + 64 * j));
    for (int row = blockIdx.x * 8 + wave; row < NTOK; row += gridDim.x * 8) norm_row<FINAL>(row, src, d1, d2, gv, dsth, dstf, lane, xb);
}

__device__ __forceinline__ void phase_prep(const Params& P, LAS unsigned char* lds, int tid) {
    const int wave = tid >> 6, lane = tid & 63;
    LAS float* scr = (LAS float*)(lds + wave * 8704);
    const int gw = blockIdx.x * 8 + wave, NGW = gridDim.x * 8;
    constexpr int I_IN = (DM / 64) * (DIN / 32), I_OUT = (DM / 64) * (DM / 32);
    bf16_t* win = (bf16_t*)(P.ws + WS_WIN); bf16_t* wout = (bf16_t*)(P.ws + WS_WOUT);
    static_assert(2 * (I_IN + I_OUT) == 256 * 75 && NTOK == 256 * 128, "interleave pattern");
    f32x4 gv[8];
#pragma unroll
    for (int j = 0; j < 8; ++j) gv[j] = *(const f32x4*)(P.norm_gain + 4 * (lane + 64 * j));
    for (int u = gw; u < 256 * 203; u += NGW) {
        const int q = u / 203, rr = u % 203;
        if (rr >= 75) { norm_row<false>(q * 128 + (rr - 75), P.x, nullptr, nullptr, gv, (bf16_t*)(P.ws + WS_H), nullptr, lane); continue; }
        int r = q * 75 + rr;
        if (r < 2 * I_IN) { const int l = r / I_IN; r -= l * I_IN; p0_transpose_item(P.w_in + (size_t)l * DM * DIN, DM, DIN, win + (size_t)l * LDP * DM, scr, r, lane, l != 0); }
        else { r -= 2 * I_IN; const int l = r / I_OUT; r -= l * I_OUT; p0_transpose_item(P.w_out + (size_t)l * DM * DM, DM, DM, wout + (size_t)l * DM * DM, scr, r, lane, l != 0); }
    }
    const int gt = blockIdx.x * 512 + tid, NT = gridDim.x * 512;
    for (int i = gt; i < 2 * 32768; i += NT) { const int l = i >> 15, c = i & 32767; *(u32x4*)(win + (size_t)l * LDP * DM + (size_t)DIN * DM + (size_t)c * 8) = (u32x4){0u, 0u, 0u, 0u}; }
    float2* cs = (float2*)(P.ws + WS_CS);
    for (int i = gt; i < SEQ * 32; i += NT) { const int pos = i >> 5, f = i & 31;
        const float inv = exp2f(-(float)f * (13.287712379549449f / 31.0f));
        const float ang = (float)pos * inv;
        double rev = (double)ang * 0.15915494309189535; rev -= floor(rev);
        const float fr = (float)rev;
        cs[i] = make_float2(__builtin_amdgcn_cosf(fr), __builtin_amdgcn_sinf(fr)); }
}

constexpr int L_T0 = 0, L_T1 = 16384, L_T2 = 32768, L_T3 = 49152, L_T4 = 65536, L_AUX = 98304;

template <int DK>
__device__ __forceinline__ void ds_core(LAS unsigned char* kd, LAS unsigned char* vt, bf16_t* ST, int w, int lane) {
    const int g = lane >> 4, c15 = lane & 15;
    constexpr int NVB = (DK == 128) ? 8 : 4;
    const int kb = (DK == 128) ? w : (w & 3), vb0 = (DK == 128) ? 0 : 4 * (w >> 2);
    const unsigned ka = tr_addr<false>(lane, kb), ka1 = tr_addr_n1(lane, kb);
    bf16x8 a[2], vf[2][NVB];
#pragma unroll
    for (int ks = 0; ks < 2; ++ks) { a[ks] = tr_frag_n(kd, ka, ka1, ks);
#pragma unroll
        for (int i = 0; i < NVB; ++i) vf[ks][i] = tr_frag_n(vt, tr_addr<false>(lane, vb0 + i), tr_addr_n1(lane, vb0 + i), ks); }
    f32x4 acc[NVB];
#pragma unroll
    for (int i = 0; i < NVB; ++i) acc[i] = (f32x4){0.f, 0.f, 0.f, 0.f};
    __builtin_amdgcn_s_setprio(1);
#pragma unroll
    for (int ks = 0; ks < 2; ++ks)
#pragma unroll
        for (int i = 0; i < NVB; ++i) acc[i] = mfma16(a[ks], vf[ks][i], acc[i]);
    __builtin_amdgcn_s_setprio(0);
#pragma unroll
    for (int i = 0; i < NVB; ++i) { const int vb = vb0 + i;
        u32x2 o; o.x = cvt_pk_bf16(acc[i][0], acc[i][1]); o.y = cvt_pk_bf16(acc[i][2], acc[i][3]);
        *(u32x2*)(ST + (size_t)(16 * vb + c15) * DK + 16 * kb + 4 * g) = o; }
}

template <int DK, bool ISC>
__device__ __forceinline__ void out_core(LAS unsigned char* qs, LAS unsigned char* ks, LAS unsigned char* qi, LAS unsigned char* vt, LAS unsigned char* st, LAS float* red,
                                         float gl2, LAS unsigned char* gate, const float* gain, bf16_t* y, int w, int lane) {
    constexpr int KS = DK / 32;
    const int tb = w & 3, vh = w >> 2, g = lane >> 4, c15 = lane & 15, t = 16 * tb + c15;
    unsigned ra[KS];
#pragma unroll
    for (int kk = 0; kk < KS; ++kk) ra[kk] = row_addr(lane, kk);
    bf16x8 qf[KS], qif[KS];
#pragma unroll
    for (int kk = 0; kk < KS; ++kk) qf[kk] = row_frag_a(qs, ra[kk], tb);
    f32x4 accs[4];
#pragma unroll
    for (int sb = 0; sb < 4; ++sb) accs[sb] = (f32x4){0.f, 0.f, 0.f, 0.f};
    {   bf16x8 kf[2][4];
#pragma unroll
        for (int sb = 0; sb < 4; ++sb) kf[0][sb] = row_frag_a(ks, ra[0], sb);
#pragma unroll
        for (int kk = 0; kk < KS; ++kk) {
            if (kk + 1 < KS) {
#pragma unroll
                for (int sb = 0; sb < 4; ++sb) kf[(kk + 1) & 1][sb] = row_frag_a(ks, ra[kk + 1 < KS ? kk + 1 : 0], sb); }
#pragma unroll
            for (int sb = 0; sb < 4; ++sb) accs[sb] = mfma16(kf[kk & 1][sb], qf[kk], accs[sb]); } }
#pragma unroll
    for (int kk = 0; kk < KS; ++kk) qif[kk] = row_frag_a(qi, ra[kk], tb);
    unsigned va[4];
#pragma unroll
    for (int i = 0; i < 4; ++i) va[i] = tr_addr<true>(lane, vh * 4 + i);
    constexpr int NS = 2 + KS;
    bf16x8 fa[2][4];
#pragma unroll
    for (int i = 0; i < 4; ++i) fa[0][i] = tr_frag_a<true>(vt, va[i], 0);
#pragma unroll
    for (int sb = 0; sb < 4; ++sb)
#pragma unroll
        for (int r = 0; r < 4; ++r) { const int s = 16 * sb + 4 * g + r; float v = accs[sb][r];
            if (ISC) v *= exp2f(gl2 * (float)(t - s));
            accs[sb][r] = (s <= t) ? v : 0.f; }
    bf16x8 pf[2]; pf[0] = pack8(accs[0], accs[1]); pf[1] = pack8(accs[2], accs[3]);
    f32x4 acco[4]; float ss = 0.f;
#pragma unroll
    for (int i = 0; i < 4; ++i) acco[i] = (f32x4){0.f, 0.f, 0.f, 0.f};
#pragma unroll
    for (int s = 0; s < NS; ++s) {
        if (s + 1 < NS) {
#pragma unroll
            for (int i = 0; i < 4; ++i) fa[(s + 1) & 1][i] = (s + 1 < 2) ? tr_frag_a<true>(vt, va[i], 1) : row_frag_a(st, ra[(s + 1 >= 2 && s + 1 < NS) ? s - 1 : 0], vh * 4 + i); }
        const bf16x8 bop = (s < 2) ? pf[s < 2 ? s : 0] : qif[(s >= 2) ? s - 2 : 0];
#pragma unroll
        for (int i = 0; i < 4; ++i) acco[i] = mfma16(fa[s & 1][i], bop, acco[i]); }
#pragma unroll
    for (int i = 0; i < 4; ++i) ss += (acco[i][0] * acco[i][0] + acco[i][1] * acco[i][1]) + (acco[i][2] * acco[i][2] + acco[i][3] * acco[i][3]);
    ss += __shfl_xor(ss, 16); ss += __shfl_xor(ss, 32);
    if (g == 0) red[vh * 64 + t] = ss;
    u32x2 gtv[4];
#pragma unroll
    for (int i = 0; i < 4; ++i) gtv[i] = *(const LAS u32x2*)(gate + t * 256 + 2 * (16 * (vh * 4 + i) + 4 * g));
    __syncthreads();
    const float rinv = rsqrtf((red[t] + red[64 + t]) * (1.f / 128.f) + EPSN);
#pragma unroll
    for (int i = 0; i < 4; ++i) { const int v0 = 16 * (vh * 4 + i) + 4 * g;
        const u32x2 gt2 = gtv[i];
        f32x4 gn = (f32x4){1.f, 1.f, 1.f, 1.f}; if (!ISC) gn = *(const f32x4*)(gain + v0);
        const float o0 = acco[i][0] * rinv * gn[0] * silu_f(bflo(gt2.x)), o1 = acco[i][1] * rinv * gn[1] * silu_f(bfhi(gt2.x));
        const float o2 = acco[i][2] * rinv * gn[2] * silu_f(bflo(gt2.y)), o3 = acco[i][3] * rinv * gn[3] * silu_f(bfhi(gt2.y));
        u32x2 o; o.x = cvt_pk_bf16(o0, o1); o.y = cvt_pk_bf16(o2, o3);
        *(u32x2*)(y + (size_t)t * DM + v0) = o; }
}

__device__ __forceinline__ float lb_of(const Params& P, int layer, int k) {
    if (layer == 0) return 0.f;
    const float l0 = P.lb_logits[k], l1 = P.lb_logits[768 + k];
    return rcp_f(1.f + __expf(l0 - l1));
}

constexpr int R_Z = 0, R_Q = 16384, R_2 = 32768, R_V = 49152, R_ST = 65536, R_G = 98304, R_AUX = 131072;
__device__ __forceinline__ void raw_put(LAS unsigned char* reg, int i, u32x4 v) { *(LAS u32x4*)(reg + (i >> 4) * 256 + (i & 15) * 16) = v; }
__device__ __forceinline__ void swz_put(LAS unsigned char* reg, int i, u32x4 v) { *(LAS u32x4*)(reg + off_b((unsigned)(i >> 4), (unsigned)(i & 15))) = v; }
__device__ __forceinline__ float raw_get(LAS unsigned char* reg, int row, int col) { return bf2f(*(const LAS bf16_t*)(reg + row * 256 + 2 * col)); }

struct A1Regs { u32x4 z[2], v[2]; };
__device__ __forceinline__ void a1_load(A1Regs& R, const Params& P, int item, int tid) {
    const int cidx = item / 6, h = item % 6; const bf16_t* proj = (const bf16_t*)(P.ws + WS_PROJ);
#pragma unroll
    for (int u = 0; u < 2; ++u) { const int i = tid + 512 * u; const size_t o = (size_t)(cidx * 64 + (i >> 4)) * 128 + (i & 15) * 8;
        R.z[u] = *(const u32x4*)(pjp(proj, AF, 128, h, 0) + o); R.v[u] = *(const u32x4*)(pjp(proj, AI, 128, h, 0) + o); }
}
__device__ __forceinline__ void a1_phase(const Params& P, int layer, LAS unsigned char* lds, int tid) {
    const int w = tid >> 6, lane = tid & 63, kp = tid & 63, G = gridDim.x;
    LAS float* part = (LAS float*)(lds + R_AUX);
    A1Regs R; int it = blockIdx.x; if (it < 3072) a1_load(R, P, it, tid);
    for (; it < 3072; it += G) {
        const int cidx = it / 6, h = it % 6;
        const float lb0 = lb_of(P, layer, h * 128 + 2 * kp), lb1 = lb_of(P, layer, h * 128 + 2 * kp + 1), om0 = 1.f - lb0, om1 = 1.f - lb1;
#pragma unroll
        for (int u = 0; u < 2; ++u) { raw_put(lds + R_Q, tid + 512 * u, R.z[u]); swz_put(lds + R_V, tid + 512 * u, R.v[u]); }
        __syncthreads();
        if (it + G < 3072) a1_load(R, P, it + G, tid);
        float f0[8], f1[8]; float t0 = 1.f, t1 = 1.f;
#pragma unroll
        for (int i = 0; i < 8; ++i) { const unsigned zz = *(const LAS unsigned*)(lds + R_Q + (8 * w + i) * 256 + 4 * kp);
            f0[i] = lb0 + om0 * rcp_f(1.f + __expf(-bflo(zz))); f1[i] = lb1 + om1 * rcp_f(1.f + __expf(-bfhi(zz))); t0 *= f0[i]; t1 *= f1[i]; }
        *(LAS f32x2*)(part + w * 128 + 2 * kp) = (f32x2){t0, t1};
        __syncthreads();
        float s0 = 1.f, s1 = 1.f, p0 = 1.f, p1 = 1.f;
#pragma unroll
        for (int g2 = 0; g2 < 8; ++g2) { const f32x2 tv = *(const LAS f32x2*)(part + g2 * 128 + 2 * kp); p0 *= tv[0]; p1 *= tv[1]; if (g2 > w) { s0 *= tv[0]; s1 *= tv[1]; } }
#pragma unroll
        for (int i = 7; i >= 0; --i) { const int row = 8 * w + i;
            *(LAS unsigned*)(lds + R_Z + off_b((unsigned)row, (unsigned)(kp >> 2)) + 4 * (kp & 3)) = cvt_pk_bf16((1.f - f0[i]) * s0, (1.f - f1[i]) * s1);
            s0 *= f0[i]; s1 *= f1[i]; }
        if (w == 0) *(f32x2*)((float*)(P.ws + WS_DEC) + (size_t)(cidx * 6 + h) * 128 + 2 * kp) = (f32x2){p0, p1};
        __syncthreads();
        ds_core<128>(lds + R_Z, lds + R_V, (bf16_t*)(P.ws + WS_STA) + (size_t)(cidx * 6 + h) * 16384, w, lane);
        __syncthreads();
    }
}
struct A3Regs { u32x4 z[2], q[2], v[2], g[2], st[4]; };
__device__ __forceinline__ void a3_load(A3Regs& R, const Params& P, int item, int tid) {
    const int cidx = item / 6, h = item % 6; const bf16_t* proj = (const bf16_t*)(P.ws + WS_PROJ);
#pragma unroll
    for (int u = 0; u < 2; ++u) { const int i = tid + 512 * u; const size_t o = (size_t)(cidx * 64 + (i >> 4)) * 128 + (i & 15) * 8;
        R.z[u] = *(const u32x4*)(pjp(proj, AF, 128, h, 0) + o); R.q[u] = *(const u32x4*)(pjp(proj, AQ, 128, h, 0) + o); R.v[u] = *(const u32x4*)(pjp(proj, AI, 128, h, 0) + o); R.g[u] = *(const u32x4*)(pjp(proj, AG, 128, h, 0) + o); }
    const bf16_t* st = (const bf16_t*)(P.ws + WS_STA) + (size_t)(cidx * 6 + h) * 16384;
#pragma unroll
    for (int u = 0; u < 4; ++u) R.st[u] = *(const u32x4*)(st + (size_t)(tid + 512 * u) * 8);
}
__device__ __forceinline__ void a3_phase(const Params& P, int layer, LAS unsigned char* lds, int tid) {
    const int w = tid >> 6, lane = tid & 63, kp = tid & 63, G = gridDim.x;
    LAS float* part = (LAS float*)(lds + R_AUX);
    A3Regs R; int it = blockIdx.x; if (it < 3072) a3_load(R, P, it, tid);
    for (; it < 3072; it += G) {
        const int cidx = it / 6, h = it % 6, tok0 = cidx * 64;
        const float lb0 = lb_of(P, layer, h * 128 + 2 * kp), lb1 = lb_of(P, layer, h * 128 + 2 * kp + 1), om0 = 1.f - lb0, om1 = 1.f - lb1;
#pragma unroll
        for (int u = 0; u < 2; ++u) { const int i = tid + 512 * u; raw_put(lds + R_Z, i, R.z[u]); raw_put(lds + R_Q, i, R.q[u]); swz_put(lds + R_V, i, R.v[u]); raw_put(lds + R_G, i, R.g[u]); }
#pragma unroll
        for (int u = 0; u < 4; ++u) swz_put(lds + R_ST, tid + 512 * u, R.st[u]);
        __syncthreads();
        if (it + G < 3072) a3_load(R, P, it + G, tid);
        float f0[8], f1[8], q0[8], q1[8]; float t0 = 1.f, t1 = 1.f;
#pragma unroll
        for (int i = 0; i < 8; ++i) { const unsigned zz = *(const LAS unsigned*)(lds + R_Z + (8 * w + i) * 256 + 4 * kp), qq = *(const LAS unsigned*)(lds + R_Q + (8 * w + i) * 256 + 4 * kp);
            f0[i] = lb0 + om0 * rcp_f(1.f + __expf(-bflo(zz))); f1[i] = lb1 + om1 * rcp_f(1.f + __expf(-bfhi(zz))); t0 *= f0[i]; t1 *= f1[i];
            q0[i] = silu_f(bflo(qq)) * 0.08838834764831845f; q1[i] = silu_f(bfhi(qq)) * 0.08838834764831845f; }
        *(LAS f32x2*)(part + w * 128 + 2 * kp) = (f32x2){t0, t1};
        __syncthreads();
        float p0 = 1.f, p1 = 1.f, x0 = 1.f, x1 = 1.f;
#pragma unroll
        for (int g2 = 0; g2 < 8; ++g2) { const f32x2 tv = *(const LAS f32x2*)(part + g2 * 128 + 2 * kp);
            if (g2 < w) { p0 *= tv[0]; p1 *= tv[1]; }
            if ((w < 4) ? (g2 > w && g2 < 4) : (g2 >= 4 && g2 < w)) { x0 *= tv[0]; x1 *= tv[1]; } }
#define A3_PUT(REG, ROW, VA, VB) *(LAS unsigned*)(lds + (REG) + off_b((unsigned)(ROW), (unsigned)(kp >> 2)) + 4 * (kp & 3)) = cvt_pk_bf16((VA), (VB))
        if (w >= 4) {
#pragma unroll
            for (int i = 0; i < 8; ++i) { const int row = 8 * w + i; p0 *= f0[i]; p1 *= f1[i]; x0 *= f0[i]; x1 *= f1[i];
                A3_PUT(R_2, row, q0[i] * p0, q1[i] * p1);
                A3_PUT(R_Z, row, q0[i] * x0, q1[i] * x1);
                A3_PUT(R_Q, row, (1.f - f0[i]) * rcp_f(fmaxf(x0, 1e-35f)), (1.f - f1[i]) * rcp_f(fmaxf(x1, 1e-35f))); }
        } else {
#pragma unroll
            for (int i = 0; i < 8; ++i) { p0 *= f0[i]; p1 *= f1[i]; A3_PUT(R_2, 8 * w + i, q0[i] * p0, q1[i] * p1); }
#pragma unroll
            for (int i = 7; i >= 0; --i) { const int row = 8 * w + i;
                A3_PUT(R_Z, row, q0[i] * rcp_f(fmaxf(x0, 1e-35f)), q1[i] * rcp_f(fmaxf(x1, 1e-35f)));
                A3_PUT(R_Q, row, (1.f - f0[i]) * x0, (1.f - f1[i]) * x1);
                x0 *= f0[i]; x1 *= f1[i]; }
        }
#undef A3_PUT
        __syncthreads();
        out_core<128, false>(lds + R_Z, lds + R_Q, lds + R_2, lds + R_V, lds + R_ST, part + 1024, 0.f,
                             lds + R_G, P.hg_gain + layer * 128, (bf16_t*)(P.ws + WS_H) + (size_t)tok0 * DM + YA + h * 128, w, lane);
    }
}
__device__ __forceinline__ float c_gl2(int h) { return log2f(1.f - exp2f(-5.f - (float)h)); }
struct C1Regs { u32x4 kq, v[2]; f32x4 cs[2]; };
__device__ __forceinline__ void c_load_cs(f32x4 (&csr)[2], const Params& P, int n, int tid) {
    const float* cs = (const float*)(P.ws + WS_CS);
#pragma unroll
    for (int u = 0; u < 2; ++u) csr[u] = *(const f32x4*)(cs + ((size_t)(n * 64 + (tid >> 4) + 32 * u) * 32 + 2 * (tid & 15)) * 2);
}
#define C_PUT(REG, ROW, COL, VA, VB) *(LAS unsigned*)(lds + (REG) + off_b((unsigned)(ROW), (unsigned)((COL) >> 3)) + 2 * ((COL) & 7)) = cvt_pk_bf16((VA), (VB))
__device__ __forceinline__ void c1_load(C1Regs& R, const Params& P, int item, int tid) {
    const int cidx = item / 5, h = item % 5, n = cidx & 255; const bf16_t* proj = (const bf16_t*)(P.ws + WS_PROJ);
    R.kq = *(const u32x4*)(pjp(proj, CK, 64, h, cidx * 64 + (tid >> 3)) + (tid & 7) * 8);
#pragma unroll
    for (int u = 0; u < 2; ++u) { const int i = tid + 512 * u; R.v[u] = *(const u32x4*)(pjp(proj, CV, 128, h, cidx * 64 + (i >> 4)) + (i & 15) * 8); }
    c_load_cs(R.cs, P, n, tid);
}
__device__ __forceinline__ void c1_phase(const Params& P, LAS unsigned char* lds, int tid) {
    const int w = tid >> 6, lane = tid & 63, ip = tid & 15, i0 = 2 * ip, r0 = tid >> 4, G = gridDim.x;
    C1Regs R; int it = blockIdx.x; if (it < 2560) c1_load(R, P, it, tid);
    for (; it < 2560; it += G) {
        const int cidx = it / 5, h = it % 5; const float gl2 = c_gl2(h);
        *(LAS u32x4*)(lds + R_Q + (tid >> 3) * 256 + (tid & 7) * 16) = R.kq;
#pragma unroll
        for (int u = 0; u < 2; ++u) swz_put(lds + R_V, tid + 512 * u, R.v[u]);
        f32x4 cs[2];
#pragma unroll
        for (int u = 0; u < 2; ++u) cs[u] = R.cs[u];
        __syncthreads();
        if (it + G < 2560) c1_load(R, P, it + G, tid);
#pragma unroll
        for (int u = 0; u < 2; ++u) { const int j = r0 + 32 * u; const f32x4 c = cs[u];
            const unsigned klo = *(const LAS unsigned*)(lds + R_Q + j * 256 + 4 * ip), khi = *(const LAS unsigned*)(lds + R_Q + j * 256 + 64 + 4 * ip);
            const float sc = 0.125f * exp2f(gl2 * (float)(63 - j));
            const float a1 = bflo(klo), a2 = bflo(khi), b1 = bfhi(klo), b2 = bfhi(khi);
            C_PUT(R_Z, j, i0, (a1 * c[0] - a2 * c[1]) * sc, (b1 * c[2] - b2 * c[3]) * sc);
            C_PUT(R_Z, j, 32 + i0, (a1 * c[1] + a2 * c[0]) * sc, (b1 * c[3] + b2 * c[2]) * sc); }
        __syncthreads();
        ds_core<64>(lds + R_Z, lds + R_V, (bf16_t*)(P.ws + WS_STC) + (size_t)(cidx * 5 + h) * 8192, w, lane);
        __syncthreads();
    }
}
struct C3Regs { u32x4 q, kk, v[2], g[2], st[2]; f32x4 cs[2]; };
__device__ __forceinline__ void c3_load(C3Regs& R, const Params& P, int item, int tid) {
    const int cidx = item / 5, h = item % 5, n = cidx & 255; const bf16_t* proj = (const bf16_t*)(P.ws + WS_PROJ);
    { const size_t o = (size_t)(cidx * 64 + (tid >> 3)) * 64 + (tid & 7) * 8; R.q = *(const u32x4*)(pjp(proj, CQ, 64, h, 0) + o); R.kk = *(const u32x4*)(pjp(proj, CK, 64, h, 0) + o); }
#pragma unroll
    for (int u = 0; u < 2; ++u) { const int i = tid + 512 * u; const size_t o = (size_t)(cidx * 64 + (i >> 4)) * 128 + (i & 15) * 8;
        R.v[u] = *(const u32x4*)(pjp(proj, CV, 128, h, 0) + o); R.g[u] = *(const u32x4*)(pjp(proj, CG, 128, h, 0) + o); }
    const bf16_t* st = (const bf16_t*)(P.ws + WS_STC) + (size_t)(cidx * 5 + h) * 8192;
#pragma unroll
    for (int u = 0; u < 2; ++u) R.st[u] = *(const u32x4*)(st + (size_t)(tid + 512 * u) * 8);
    c_load_cs(R.cs, P, n, tid);
}
__device__ __forceinline__ void c3_phase(const Params& P, LAS unsigned char* lds, int tid) {
    const int w = tid >> 6, lane = tid & 63, ip = tid & 15, i0 = 2 * ip, r0 = tid >> 4, G = gridDim.x;
    C3Regs R; int it = blockIdx.x; if (it < 2560) c3_load(R, P, it, tid);
    for (; it < 2560; it += G) {
        const int cidx = it / 5, h = it % 5, tok0 = cidx * 64; const float gl2 = c_gl2(h);
        *(LAS u32x4*)(lds + R_G + 16384 + (tid >> 3) * 256 + (tid & 7) * 16) = R.q;
        *(LAS u32x4*)(lds + R_G + 16384 + (tid >> 3) * 256 + 128 + (tid & 7) * 16) = R.kk;
#pragma unroll
        for (int u = 0; u < 2; ++u) { const int c = tid + 512 * u; swz_put(lds + R_V, c, R.v[u]); raw_put(lds + R_G, c, R.g[u]);
            *(LAS u32x4*)(lds + R_ST + off_b((unsigned)(c >> 3), (unsigned)(c & 7))) = R.st[u]; }
        f32x4 cs[2];
#pragma unroll
        for (int u = 0; u < 2; ++u) cs[u] = R.cs[u];
        __syncthreads();
        if (it + G < 2560) c3_load(R, P, it + G, tid);
        LAS unsigned char* rqk = lds + R_G + 16384;
#pragma unroll
        for (int u = 0; u < 2; ++u) { const int j = r0 + 32 * u; const f32x4 c = cs[u];
            const unsigned qlo = *(const LAS unsigned*)(rqk + j * 256 + 4 * ip), qhi = *(const LAS unsigned*)(rqk + j * 256 + 64 + 4 * ip);
            const unsigned klo = *(const LAS unsigned*)(rqk + j * 256 + 128 + 4 * ip), khi = *(const LAS unsigned*)(rqk + j * 256 + 192 + 4 * ip);
            const float dq = exp2f(gl2 * (float)(j + 1));
            const float qa0 = bflo(qlo) * c[0] - bflo(qhi) * c[1], qb0 = bflo(qlo) * c[1] + bflo(qhi) * c[0];
            const float qa1 = bfhi(qlo) * c[2] - bfhi(qhi) * c[3], qb1 = bfhi(qlo) * c[3] + bfhi(qhi) * c[2];
            C_PUT(R_Z, j, i0, qa0, qa1); C_PUT(R_Z, j, 32 + i0, qb0, qb1);
            C_PUT(R_2, j, i0, qa0 * dq, qa1 * dq); C_PUT(R_2, j, 32 + i0, qb0 * dq, qb1 * dq);
            C_PUT(R_Q, j, i0, (bflo(klo) * c[0] - bflo(khi) * c[1]) * 0.125f, (bfhi(klo) * c[2] - bfhi(khi) * c[3]) * 0.125f);
            C_PUT(R_Q, j, 32 + i0, (bflo(klo) * c[1] + bflo(khi) * c[0]) * 0.125f, (bfhi(klo) * c[3] + bfhi(khi) * c[2]) * 0.125f); }
        __syncthreads();
        out_core<64, true>(lds + R_Z, lds + R_Q, lds + R_2, lds + R_V, lds + R_ST, (LAS float*)(lds + R_AUX) + 512, gl2,
                           lds + R_G, nullptr, (bf16_t*)(P.ws + WS_H) + (size_t)tok0 * DM + YC + h * 128, w, lane);
    }
}
#undef C_PUT

__device__ __forceinline__ void b_item(const Params& P, int layer, LAS unsigned char* lds, int item, int tid) {
    const int b = item / 320, rem = item % 320, h = rem / 64, m = rem % 64, w = tid >> 6, lane = tid & 63;
    const int qc = w >> 1, th = w & 1, g = lane >> 4, c15 = lane & 15;
    const bf16_t* proj = (const bf16_t*)(P.ws + WS_PROJ);
    const size_t tok0 = (size_t)b * SEQ + (size_t)m * 256;
    LAS unsigned char* Qt = lds + 0; LAS unsigned char* KV = lds + 65536; LAS float* bias = (LAS float*)(lds + 131072);
    tile_load<256, 16>(Qt, pjp(proj, BQ, 128, h, tok0), 128, tid);
    for (int i = tid; i < 257; i += 512) bias[i] = P.rel_bias[(size_t)(layer * 5 + h) * 257 + i];
    const int jst = (8 - 4 * m) > 0 ? (8 - 4 * m) : 0;
    const long krow = (long)b * SEQ + (long)(4 * m - 8) * 64;
    const bf16_t* kbase = pjp(proj, BKC, 128, h, 0) + krow * 128; const bf16_t* vbase = pjp(proj, BV, 128, h, 0) + krow * 128;
    unsigned soff[2];
#pragma unroll
    for (int u = 0; u < 2; ++u) { const unsigned i = tid + 512 * u, row = i >> 4, ch = (i & 15) ^ (((row & 3u) << 2) | ((row >> 2) & 3u)); soff[u] = row * 128 + ch * 8; }
    const unsigned ldsw = (unsigned)__builtin_amdgcn_readfirstlane(w) * 1024u;
#define B_DMA(J, BUF) do { const long jo_ = (long)(J) * 64 * 128; _Pragma("unroll") for (int u = 0; u < 2; ++u) { \
        __builtin_amdgcn_global_load_lds((const unsigned*)(kbase + jo_ + soff[u]), (LAS unsigned*)(KV + (BUF) * 32768 + ldsw + u * 8192), 16, 0, 0); \
        __builtin_amdgcn_global_load_lds((const unsigned*)(vbase + jo_ + soff[u]), (LAS unsigned*)(KV + (BUF) * 32768 + 16384 + ldsw + u * 8192), 16, 0, 0); } } while (0)
    B_DMA(jst, 0);
    __syncthreads();
    LAS unsigned char* Qw = Qt + 4096 * (qc * 4 + th * 2);
    float mrun[2] = {-1e30f, -1e30f}, lrun[2] = {0.f, 0.f}; const float bfar = bias[256];
    unsigned kaddr[4], vaddr[8];
#pragma unroll
    for (int kk = 0; kk < 4; ++kk) kaddr[kk] = row_addr(lane, kk);
#pragma unroll
    for (int vb = 0; vb < 8; ++vb) vaddr[vb] = tr_addr<true>(lane, vb);
    f32x4 acco[2][8];
#pragma unroll
    for (int u = 0; u < 2; ++u)
#pragma unroll
        for (int i = 0; i < 8; ++i) acco[u][i] = (f32x4){0.f, 0.f, 0.f, 0.f};
    auto step = [&](int j, LAS unsigned char* Kt, LAS unsigned char* Vt) {
        const bool active = (j >= qc) && (j <= qc + 8);
        if (active) {
            const int dl = 64 * (8 + qc - j);
            f32x4 accs[2][4];
#pragma unroll
            for (int sb = 0; sb < 4; ++sb) { accs[0][sb] = (f32x4){0.f, 0.f, 0.f, 0.f}; accs[1][sb] = (f32x4){0.f, 0.f, 0.f, 0.f}; }
            __builtin_amdgcn_s_setprio(1);
#pragma unroll
            for (int kk = 0; kk < 4; ++kk) { const bf16x8 q0 = row_frag_a(Qw, kaddr[kk], 0), q1 = row_frag_a(Qw, kaddr[kk], 1);
#pragma unroll
                for (int sb = 0; sb < 4; ++sb) { const bf16x8 kf = row_frag_a(Kt, kaddr[kk], sb);
                    accs[0][sb] = mfma16(kf, q0, accs[0][sb]); accs[1][sb] = mfma16(kf, q1, accs[1][sb]); } }
            __builtin_amdgcn_s_setprio(0);
            bf16x8 pf[2][2]; float alpha[2];
#pragma unroll
            for (int u = 0; u < 2; ++u) { const int t = 32 * th + 16 * u + c15; float mt = -1e30f;
#pragma unroll
                for (int sb = 0; sb < 4; ++sb) {
                    if (dl >= 192) {
#pragma unroll
                        for (int r = 0; r < 4; ++r) { const float xv = accs[u][sb][r] * 0.08838834764831845f + bfar; accs[u][sb][r] = xv; mt = fmaxf(mt, xv); }
                    } else {
#pragma unroll
                        for (int r = 0; r < 4; ++r) { const int s = 16 * sb + 4 * g + r; int rel = t - s + dl; rel = rel > 128 ? 128 : rel;
                            const float xv = accs[u][sb][r] * 0.08838834764831845f + bias[rel + 128]; accs[u][sb][r] = xv; mt = fmaxf(mt, xv); } } }
                mt = fmaxf(mt, __shfl_xor(mt, 16)); mt = fmaxf(mt, __shfl_xor(mt, 32));
                const float mn = fmaxf(mrun[u], mt); alpha[u] = __expf(mrun[u] - mn); mrun[u] = mn;
                float ls = 0.f;
#pragma unroll
                for (int sb = 0; sb < 4; ++sb)
#pragma unroll
                    for (int r = 0; r < 4; ++r) { const float pe = __expf(accs[u][sb][r] - mn); accs[u][sb][r] = pe; ls += pe; }
                lrun[u] = lrun[u] * alpha[u] + ls;
                pf[u][0] = pack8(accs[u][0], accs[u][1]); pf[u][1] = pack8(accs[u][2], accs[u][3]); }
            __builtin_amdgcn_s_setprio(1);
#pragma unroll
            for (int vb = 0; vb < 8; ++vb) { acco[0][vb] = acco[0][vb] * alpha[0]; acco[1][vb] = acco[1][vb] * alpha[1];
#pragma unroll
                for (int ks = 0; ks < 2; ++ks) { const bf16x8 vf = tr_frag_a<true>(Vt, vaddr[vb], ks);
                    acco[0][vb] = mfma16(vf, pf[0][ks], acco[0][vb]); acco[1][vb] = mfma16(vf, pf[1][ks], acco[1][vb]); } }
            __builtin_amdgcn_s_setprio(0);
        }
    };
#pragma unroll 1
    for (int j = jst; j < 12; ++j) {
        const int buf = (j - jst) & 1;
        asm volatile("s_waitcnt vmcnt(0)" ::: "memory");
        __syncthreads();
        if (j + 1 < 12) B_DMA(j + 1, buf ^ 1);
        step(j, KV + buf * 32768, KV + buf * 32768 + 16384);
    }
    __syncthreads();
#undef B_DMA
#pragma unroll
    for (int u = 0; u < 2; ++u) {
        float l = lrun[u]; l += __shfl_xor(l, 16); l += __shfl_xor(l, 32);
        const float inv = rcp_f(l);
        const size_t tok = tok0 + 64 * qc + 32 * th + 16 * u + c15;
        const bf16_t* gate = pjp(proj, BG, 128, h, tok);
        bf16_t* y = (bf16_t*)(P.ws + WS_H) + tok * DM + YB + h * 128;
#pragma unroll
        for (int vb = 0; vb < 8; ++vb) { const int v0 = 16 * vb + 4 * g; const u32x2 gt2 = *(const u32x2*)(gate + v0);
            u32x2 o; o.x = cvt_pk_bf16(acco[u][vb][0] * inv * silu_f(bflo(gt2.x)), acco[u][vb][1] * inv * silu_f(bfhi(gt2.x)));
            o.y = cvt_pk_bf16(acco[u][vb][2] * inv * silu_f(bflo(gt2.y)), acco[u][vb][3] * inv * silu_f(bfhi(gt2.y)));
            *(u32x2*)(y + v0) = o; }
    }
}

__device__ __forceinline__ void phase_scan(const Params& P, int tid) {
    const int gt = blockIdx.x * 512 + tid, NT = gridDim.x * 512;
    for (int idx = gt; idx < 49152 + 20480; idx += NT) {
        if (idx < 49152) {
            const int bh = idx >> 12, e = (idx & 4095) * 4, b = bh / 6, h = bh % 6, k = e & 127;
            bf16_t* sp = (bf16_t*)(P.ws + WS_STA) + (size_t)(b * 256 * 6 + h) * 16384 + e;
            const float* dp = (const float*)(P.ws + WS_DEC) + (size_t)(b * 256 * 6 + h) * 128 + k;
            f32x4 S = (f32x4){0.f, 0.f, 0.f, 0.f};
            for (int n0 = 0; n0 < 256; n0 += 16) {
                u32x2 d[16]; f32x4 dc[16];
#pragma unroll
                for (int j = 0; j < 16; ++j) { d[j] = *(const u32x2*)(sp + (size_t)(n0 + j) * (6 * 16384)); dc[j] = *(const f32x4*)(dp + (size_t)(n0 + j) * 768); }
#pragma unroll
                for (int j = 0; j < 16; ++j) { u32x2 o; o.x = cvt_pk_bf16(S[0], S[1]); o.y = cvt_pk_bf16(S[2], S[3]);
                    S[0] = dc[j][0] * S[0] + bflo(d[j].x); S[1] = dc[j][1] * S[1] + bfhi(d[j].x); S[2] = dc[j][2] * S[2] + bflo(d[j].y); S[3] = dc[j][3] * S[3] + bfhi(d[j].y);
                    *(u32x2*)(sp + (size_t)(n0 + j) * (6 * 16384)) = o; }
            }
        } else {
            const int i2 = idx - 49152, bh = i2 >> 11, e = (i2 & 2047) * 4, b = bh / 5, h = bh % 5;
            bf16_t* sp = (bf16_t*)(P.ws + WS_STC) + (size_t)(b * 256 * 5 + h) * 8192 + e;
            const float cd = exp2f(64.f * c_gl2(h));
            f32x4 S = (f32x4){0.f, 0.f, 0.f, 0.f};
            for (int n0 = 0; n0 < 256; n0 += 16) {
                u32x2 d[16];
#pragma unroll
                for (int j = 0; j < 16; ++j) d[j] = *(const u32x2*)(sp + (size_t)(n0 + j) * (5 * 8192));
#pragma unroll
                for (int j = 0; j < 16; ++j) { u32x2 o; o.x = cvt_pk_bf16(S[0], S[1]); o.y = cvt_pk_bf16(S[2], S[3]);
                    S[0] = cd * S[0] + bflo(d[j].x); S[1] = cd * S[1] + bfhi(d[j].x); S[2] = cd * S[2] + bflo(d[j].y); S[3] = cd * S[3] + bfhi(d[j].y);
                    *(u32x2*)(sp + (size_t)(n0 + j) * (5 * 8192)) = o; }
            }
        }
    }
}

#define XB_TMO      128
#define XB_XCNT(j)  (256  + 64 * (j))
#define XB_XSUB(j)  (1280 + 64 * (j))
#define XB_XGEN(j)  (2304 + 64 * (j))
#define XB_TOP      3328
#define XB_TOPGEN   3392
#define XCD_BAR_WORDS 3456
#define XB_SPIN_CAP (1u << 18)

__device__ __forceinline__ unsigned xb_ld(unsigned* p)              { return __hip_atomic_load(p, __ATOMIC_RELAXED, __HIP_MEMORY_SCOPE_AGENT); }
__device__ __forceinline__ unsigned xb_add(unsigned* p, unsigned v) { return __hip_atomic_fetch_add(p, v, __ATOMIC_RELAXED, __HIP_MEMORY_SCOPE_AGENT); }
__device__ __forceinline__ unsigned xb_xcc_id() { return (unsigned)__builtin_amdgcn_s_getreg((3 << 11) | 20) & 0xFu; }
#define XB_SPIN(cond, bar) do { unsigned _sp = 0; while (cond) { __builtin_amdgcn_s_sleep(1); \
    if ((++_sp & 255u) == 0u) { if (xb_ld(&(bar)[XB_TMO])) break; if (_sp > XB_SPIN_CAP) { atomicAdd(&(bar)[XB_TMO], 1u); break; } } } } while (0)

struct XcdBarrier {
    unsigned* bar; unsigned x;
    volatile LAS unsigned* st;
};

__device__ __forceinline__ XcdBarrier xcd_barrier_post(unsigned* bar, volatile LAS unsigned* st) {
    XcdBarrier b; b.bar = bar; b.x = xb_xcc_id(); b.st = st;
    if (threadIdx.x == 0) (void)xb_add(&bar[XB_XCNT(b.x)], 1u);
    return b;
}
__device__ __forceinline__ void xcd_barrier_complete(unsigned* bar, unsigned x, unsigned& nloc, unsigned& nx) {
    const unsigned G = gridDim.x * gridDim.y * gridDim.z;
    unsigned sum, cnt, mine, sp = 0u;
    for (;;) {
        sum = 0u; cnt = 0u; mine = 0u;
#pragma unroll
        for (unsigned j = 0; j < 16; ++j) { const unsigned c = xb_ld(&bar[XB_XCNT(j)]); sum += c; cnt += (c > 0u) ? 1u : 0u; mine = (j == x) ? c : mine; }
        if (sum == G) break;
        __builtin_amdgcn_s_sleep(1);
        if ((++sp & 255u) == 0u) { if (xb_ld(&bar[XB_TMO])) break; if (sp > XB_SPIN_CAP) { atomicAdd(&bar[XB_TMO], 1u); break; } }
    }
    nloc = mine > 0u ? mine : 1u; nx = cnt > 0u ? cnt : 1u;
}

__device__ __forceinline__ void xcd_barrier(const XcdBarrier& b) {
    asm volatile("s_waitcnt vmcnt(0)" ::: "memory");
    __syncthreads();
    if (threadIdx.x == 0) {
        unsigned* bar = b.bar;
        __builtin_amdgcn_s_waitcnt(0);
        unsigned nloc = b.st[0], nx = b.st[1];
        if (nloc == 0u) { xcd_barrier_complete(bar, b.x, nloc, nx); b.st[0] = nloc; b.st[1] = nx; }
        const unsigned old = xb_add(&bar[XB_XSUB(b.x)], 1u);
        const unsigned gen = old / nloc;
        if (old + 1u == (gen + 1u) * nloc) {
            __builtin_amdgcn_fence(__ATOMIC_RELEASE, "agent");
            asm volatile("s_waitcnt vmcnt(0)" ::: "memory");
            const unsigned og = xb_add(&bar[XB_TOP], 1u);
            const unsigned tg = og / nx;
            if (og + 1u == (tg + 1u) * nx) xb_add(&bar[XB_TOPGEN], 1u);
            else XB_SPIN(xb_ld(&bar[XB_TOPGEN]) == tg, bar);
            __builtin_amdgcn_fence(__ATOMIC_ACQUIRE, "agent");
            xb_add(&bar[XB_XGEN(b.x)], 1u);
            asm volatile("s_waitcnt vmcnt(0)" ::: "memory");
        } else {
            XB_SPIN(xb_ld(&bar[XB_XGEN(b.x)]) == gen, bar);
            __builtin_amdgcn_fence(__ATOMIC_ACQUIRE, "agent");
            asm volatile("s_waitcnt vmcnt(0)" ::: "memory");
        }
    }
    __syncthreads();
}

__global__ __launch_bounds__(512, 2) void hybrid_fwd(Params P0) {
    extern __shared__ __attribute__((aligned(16))) unsigned char shm[];
    LAS unsigned char* lds = (LAS unsigned char*)shm;
    cg::grid_group grid = cg::this_grid();
    volatile LAS unsigned* xst = (volatile LAS unsigned*)(lds + 139248);
    if (threadIdx.x == 0) { xst[0] = 0u; xst[1] = 0u; }
    __syncthreads();
    XcdBarrier xb = xcd_barrier_post((unsigned*)(P0.ws + WS_END), xst);
    for (int ph = P0.ph_lo; ph < P0.ph_hi; ++ph) {
        if (ph > P0.ph_lo) { if (P0.ph_lo < 0) grid.sync();   xcd_barrier(xb); }
        Params P = P0; int tid = threadIdx.x;
        { size_t z0 = 0, z1 = 0, z2 = 0; asm volatile("" : "+s"(z0), "+s"(z1), "+s"(z2), "+v"(tid));
          P.ws = P0.ws + z0; P.out = P0.out + z1; P.x = P0.x + z2; P.w_in = P0.w_in + z0; P.norm_gain = P0.norm_gain + z1; P.lb_logits = P0.lb_logits + z2;
          P.hg_gain = P0.hg_gain + z0; P.rel_bias = P0.rel_bias + z1; P.w_out = P0.w_out + z2; P.final_gain = P0.final_gain + z0; }
        if (ph == 0) { phase_prep(P, lds, tid); continue; }
        const int layer = (ph - 1) / 6, sub = (ph - 1) % 6;
        {
        if (sub == 0) {
            pg8::Gemm gm{(const bf16_t*)(P.ws + WS_H), (const bf16_t*)(P.ws + WS_WIN) + (size_t)layer * LDP * DM, NTOK, LDP, DM};
            pg8::StaticOrder S; S.init(NTOK, LDP, (int)gridDim.x, (int)blockIdx.x);
            pg8::EpiProj E{(bf16_t*)(P.ws + WS_PROJ)};
            pg8::gemm_phase(lds, gm, S, E);
        } else if (sub == 1) {
            a1_phase(P, layer, lds, tid);
            c1_phase(P, lds, tid);
        } else if (sub == 2) {
            phase_scan(P, tid);
            {
                unsigned* ctr = (unsigned*)(P.ws + WS_END) + 3584 + layer; LAS int* sit = (LAS int*)(lds + 132608);
                for (;;) {
                    if (tid == 0) *sit = (int)atomicAdd(ctr, 1u);
                    __syncthreads();
                    const int it = *sit;
                    __syncthreads();
                    if (it >= 640) break;
                    b_item(P, layer, lds, it, tid);
                }
            }
        } else if (sub == 3) {
            a3_phase(P, layer, lds, tid); __syncthreads();
            c3_phase(P, lds, tid);
        } else if (sub == 4) {
            pg8::Gemm gm{(const bf16_t*)(P.ws + WS_H), (const bf16_t*)(P.ws + WS_WOUT) + (size_t)layer * DM * DM, NTOK, DM, DM};
            pg8::StaticOrder S; S.init(NTOK, DM, (int)gridDim.x, (int)blockIdx.x);
            pg8::EpiBf16 E{(bf16_t*)(P.ws + (layer == 0 ? WS_D1 : WS_PROJ)), DM};
            pg8::gemm_phase(lds, gm, S, E);
        } else {
            if (layer == 0) phase_norm<false>(P.x, (const bf16_t*)(P.ws + WS_D1), nullptr, P.norm_gain + DM, (bf16_t*)(P.ws + WS_H), nullptr, tid, (bf16_t*)(P.ws + WS_D1));
            else phase_final((const bf16_t*)(P.ws + WS_D1), (const bf16_t*)(P.ws + WS_PROJ), P.final_gain, P.out, tid);
        }
        }
    }
}

constexpr int NPHASES = 13;
constexpr int LDS_BYTES = 131072 + 8192;

extern "C" void kernel_launch(void* const* d_in, const int* in_sizes, int n_in, void* d_out, int out_size, void* d_ws, size_t ws_size, hipStream_t stream) {
    static int grid = 0;
    if (grid == 0) {
        if (n_in != 8 || ws_size < WS_TOTAL) { fprintf(stderr, "kernel_launch: unexpected inputs (n_in %d, ws %zu < %zu)\n", n_in, ws_size, (size_t)WS_END); grid = -1; return; }
        if (hipFuncSetAttribute((const void*)hybrid_fwd, hipFuncAttributeMaxDynamicSharedMemorySize, LDS_BYTES) != hipSuccess) { fprintf(stderr, "hipFuncSetAttribute failed\n"); grid = -1; return; }
        int dev = 0, cus = 0, per_cu = 0;
        (void)hipGetDevice(&dev); (void)hipDeviceGetAttribute(&cus, hipDeviceAttributeMultiprocessorCount, dev);
        (void)hipOccupancyMaxActiveBlocksPerMultiprocessor(&per_cu, (const void*)hybrid_fwd, 512, LDS_BYTES);
        if (per_cu < 1) { fprintf(stderr, "occupancy query says 0 blocks per CU\n"); per_cu = 1; }
        (void)hipGetLastError();
        grid = cus;
    }
    if (grid < 0) return;
    Params p{};
    p.x = (const float*)d_in[0]; p.w_in = (const float*)d_in[1]; p.norm_gain = (const float*)d_in[2]; p.lb_logits = (const float*)d_in[3];
    p.hg_gain = (const float*)d_in[4]; p.rel_bias = (const float*)d_in[5]; p.w_out = (const float*)d_in[6]; p.final_gain = (const float*)d_in[7];
    p.out = (float*)d_out; p.ws = (unsigned char*)d_ws;
    if (hipMemsetAsync((unsigned char*)d_ws + WS_END, 0, WS_BARB, stream) != hipSuccess) { fprintf(stderr, "memset of the barrier words failed\n"); return; }
    p.ph_lo = 0; p.ph_hi = NPHASES;
    void* args[] = {&p};
    hipError_t e = hipLaunchCooperativeKernel((const void*)hybrid_fwd, dim3(grid), dim3(512), args, LDS_BYTES, stream);
    if (e != hipSuccess) fprintf(stderr, "cooperative launch failed: %s (grid %d)\n", hipGetErrorString(e), grid);
}
```

```cpp
#include <hip/hip_runtime.h>
#include <hip/hip_cooperative_groups.h>
#include <cstdio>
namespace cg = cooperative_groups;

#define LAS __attribute__((address_space(3)))
typedef unsigned short bf16_t;
typedef short bf16x8 __attribute__((ext_vector_type(8)));
typedef short s16x4 __attribute__((ext_vector_type(4)));
typedef float f32x4 __attribute__((ext_vector_type(4)));
typedef float f32x2 __attribute__((ext_vector_type(2)));
typedef unsigned u32x4 __attribute__((ext_vector_type(4)));
typedef unsigned u32x2 __attribute__((ext_vector_type(2)));

constexpr int NTOK = 32768, SEQ = 16384, DM = 2048, NCHB = 256  , NCH = 512;
constexpr int LDP = 7680;
constexpr int DIN = 7552;
constexpr int AQ = 0, AF = 768, AI = 1536, AG = 2304, BQ = 3072, BKC = 3712, BV = 4352, BG = 4992, CQ = 5632, CK = 5952, CV = 6272, CG = 6912;
constexpr int YA = 0, YB = 768, YC = 1408;
constexpr float EPSN = 1e-6f;

constexpr size_t WS_WIN = 0;
constexpr size_t WS_WOUT = WS_WIN + (size_t)2 * LDP * DM * 2;
constexpr size_t WS_H = WS_WOUT + (size_t)2 * DM * DM * 2;
constexpr size_t WS_PROJ = WS_H + (size_t)NTOK * DM * 2;
constexpr size_t WS_STA = WS_PROJ + (size_t)NTOK * LDP * 2;
constexpr size_t WS_STC = WS_STA + (size_t)NCH * 6 * 128 * 128 * 2;
constexpr size_t WS_DEC = WS_STC + (size_t)NCH * 5 * 128 * 64 * 2;
constexpr size_t WS_CS = WS_DEC + (size_t)NCH * 6 * 128 * 4;
constexpr size_t WS_END = WS_CS + (size_t)SEQ * 32 * 8;
constexpr size_t WS_BARB = 16384;
constexpr size_t WS_D1 = WS_END + WS_BARB;
constexpr size_t WS_RR = WS_D1 + (size_t)NTOK * DM * 2;
constexpr size_t WS_TOTAL = WS_RR + (size_t)NTOK * 4;

struct Params {
    const float *x, *w_in, *norm_gain, *lb_logits, *hg_gain, *rel_bias, *w_out, *final_gain;
    float* out; unsigned char* ws;
    int ph_lo, ph_hi;
};

__device__ __forceinline__ const bf16_t* pjp(const bf16_t* proj, int tcol, int W, int h, size_t tok) { return proj + (size_t)tcol * NTOK + ((size_t)h * NTOK + tok) * W; }
typedef __bf16 bf16x2_t __attribute__((ext_vector_type(2)));
__device__ __forceinline__ unsigned cvt_pk_bf16(float lo, float hi) { const f32x2 f = {lo, hi}; const bf16x2_t v = __builtin_convertvector(f, bf16x2_t); return __builtin_bit_cast(unsigned, v); }
__device__ __forceinline__ bf16_t f2bf(float v) { return (bf16_t)(cvt_pk_bf16(v, 0.f) & 0xffffu); }
__device__ __forceinline__ float bf2f(bf16_t u) { return __uint_as_float((unsigned)u << 16); }
__device__ __forceinline__ float bflo(unsigned u) { return __uint_as_float(u << 16); }
__device__ __forceinline__ float bfhi(unsigned u) { return __uint_as_float(u & 0xffff0000u); }
__device__ __forceinline__ float wave_sum(float v) {
#pragma unroll
    for (int o = 1; o < 64; o <<= 1) v += __shfl_xor(v, o);
    return v;
}
__device__ __forceinline__ float rcp_f(float v) { return __builtin_amdgcn_rcpf(v); }
__device__ __forceinline__ float silu_f(float v) { return v * rcp_f(1.f + __expf(-v)); }

__device__ __forceinline__ unsigned off_b(unsigned row, unsigned ch) { return 256u * row + 16u * (ch ^ (((row & 3u) << 2) | ((row >> 2) & 3u))); }
__device__ __forceinline__ bf16x8 row_frag(LAS unsigned char* tile, int rb, int s, int lane) {
    return *(const LAS bf16x8*)(tile + off_b((unsigned)((lane & 15) + 16 * rb), (unsigned)(4 * s + (lane >> 4))));
}
template <bool PERM>
__device__ __forceinline__ bf16x8 tr_frag(LAS unsigned char* tile, int c, int ks, int lane) {
    const unsigned g = lane >> 4, q = (lane & 15) >> 2, p = lane & 3;
    const unsigned r0 = 32u * ks + (PERM ? 4u * g : 8u * g) + q, r1 = r0 + (PERM ? 16u : 4u);
    const unsigned ch = 2u * c + (p >> 1), sub = 8u * (p & 1);
    const s16x4 a = __builtin_amdgcn_ds_read_tr16_b64_v4i16((LAS s16x4*)(tile + off_b(r0, ch) + sub));
    const s16x4 b = __builtin_amdgcn_ds_read_tr16_b64_v4i16((LAS s16x4*)(tile + off_b(r1, ch) + sub));
    bf16x8 r; r[0] = a[0]; r[1] = a[1]; r[2] = a[2]; r[3] = a[3]; r[4] = b[0]; r[5] = b[1]; r[6] = b[2]; r[7] = b[3]; return r;
}
__device__ __forceinline__ unsigned row_addr(int lane, int s) { return off_b((unsigned)(lane & 15), (unsigned)(4 * s + (lane >> 4))); }
__device__ __forceinline__ bf16x8 row_frag_a(LAS unsigned char* tile, unsigned addr, int rb) { return *(const LAS bf16x8*)(tile + addr + 4096 * rb); }
template <bool PERM>
__device__ __forceinline__ unsigned tr_addr(int lane, int c) { const unsigned g = lane >> 4, q = (lane & 15) >> 2, p = lane & 3;
    return off_b((PERM ? 4u * g : 8u * g) + q, 2u * c + (p >> 1)) + 8u * (p & 1); }
__device__ __forceinline__ unsigned tr_addr_n1(int lane, int c) { const unsigned g = lane >> 4, q = (lane & 15) >> 2, p = lane & 3;
    return off_b(8u * g + 4u + q, 2u * c + (p >> 1)) + 8u * (p & 1); }
__device__ __forceinline__ bf16x8 tr_frag_n(LAS unsigned char* tile, unsigned addr0, unsigned addr1, int ks) {
    const s16x4 a = __builtin_amdgcn_ds_read_tr16_b64_v4i16((LAS s16x4*)(tile + addr0 + 8192 * ks));
    const s16x4 b = __builtin_amdgcn_ds_read_tr16_b64_v4i16((LAS s16x4*)(tile + addr1 + 8192 * ks));
    bf16x8 r; r[0] = a[0]; r[1] = a[1]; r[2] = a[2]; r[3] = a[3]; r[4] = b[0]; r[5] = b[1]; r[6] = b[2]; r[7] = b[3]; return r;
}
template <bool PERM>
__device__ __forceinline__ bf16x8 tr_frag_a(LAS unsigned char* tile, unsigned addr, int ks) {
    static_assert(PERM, "natural order: use tr_frag_n");
    const s16x4 a = __builtin_amdgcn_ds_read_tr16_b64_v4i16((LAS s16x4*)(tile + addr + 8192 * ks));
    const s16x4 b = __builtin_amdgcn_ds_read_tr16_b64_v4i16((LAS s16x4*)(tile + addr + 8192 * ks + (PERM ? 4096 : 1024)));
    bf16x8 r; r[0] = a[0]; r[1] = a[1]; r[2] = a[2]; r[3] = a[3]; r[4] = b[0]; r[5] = b[1]; r[6] = b[2]; r[7] = b[3]; return r;
}
__device__ __forceinline__ f32x4 mfma16(bf16x8 a, bf16x8 b, f32x4 c) { return __builtin_amdgcn_mfma_f32_16x16x32_bf16(a, b, c, 0, 0, 0); }
__device__ __forceinline__ void lds_put(LAS unsigned char* tile, int row, int col, float v) { *(LAS bf16_t*)(tile + off_b((unsigned)row, (unsigned)(col >> 3)) + 2 * (col & 7)) = f2bf(v); }
template <int ROWS, int CH>
__device__ __forceinline__ void tile_load(LAS unsigned char* tile, const bf16_t* src, int ld, int tid) {
#pragma unroll
    for (int u = 0; u < ROWS * CH / 512; ++u) { const int i = tid + 512 * u, row = i / CH, ch = i % CH;
        *(LAS u32x4*)(tile + off_b((unsigned)row, (unsigned)ch)) = *(const u32x4*)(src + (size_t)row * ld + ch * 8); }
}
__device__ __forceinline__ bf16x8 pack8(f32x4 a, f32x4 b) {
    u32x4 w; w.x = cvt_pk_bf16(a[0], a[1]); w.y = cvt_pk_bf16(a[2], a[3]); w.z = cvt_pk_bf16(b[0], b[1]); w.w = cvt_pk_bf16(b[2], b[3]);
    return __builtin_bit_cast(bf16x8, w);
}

namespace pg8 {
constexpr int BM = 256, BK = 64, HALF = 128, HTB = HALF * BK * 2, STAGE_BYTES = 8 * HTB, NXCD = 8, WGM = 8;
__device__ __forceinline__ int lds_byte(int r, int c) { const int st = (r >> 4) * 2 + (c >> 5), rr = r & 15, cc = c & 31, ob = rr * 64 + cc * 2; return st * 1024 + (ob ^ (((ob >> 9) & 1) << 5)); }
__device__ __forceinline__ void stage_rc(int b, int& R, int& C) { const int st = b / 1024, sb = b % 1024, swz = sb ^ (((sb >> 9) & 1) << 5); R = (st >> 1) * 16 + swz / 64; C = (st & 1) * 32 + (swz % 64) / 2; }
__device__ __forceinline__ int perm32(int rho) { const int n = rho >> 4, i = rho & 15; return 8 * (i >> 2) + 4 * n + (i & 3); }
struct Unit { int pm, pn; };
struct Gemm { const bf16_t* A; const bf16_t* Bt; int M, N, K; };
struct StaticOrder {
    int nM, nN, nwg, G, c;
    __device__ void init(int M, int N, int G_, int c_) { nM = M / BM; nN = N / BM; nwg = nM * nN; G = G_; c = c_; }
    __device__ bool next(int i, Unit& u) const {
        const long L = (long)i * G + c; if (L >= nwg) return false;
        int wgid = (int)L; { const int q = nwg / NXCD, r = nwg % NXCD, xcd = wgid % NXCD, off = wgid / NXCD; wgid = (xcd < r ? xcd * (q + 1) : r * (q + 1) + (xcd - r) * q) + off; }
        const int nig = WGM * nN, gid = wgid / nig, fm = gid * WGM, gsz = (nM - fm) < WGM ? (nM - fm) : WGM;
        u.pm = fm + ((wgid % nig) % gsz); u.pn = (wgid % nig) / gsz; return true;
    }
    __device__ __forceinline__ void a_ready(const Unit&) const {}
    __device__ __forceinline__ void done(const Unit&) const {}
};
struct EpiBf16 {
    static constexpr bool PERM = true;
    bf16_t* O; int ldc;
    __device__ __forceinline__ void operator()(const f32x4 (&acc)[2][2][4][2], const Unit& u, int wr, int wc, int fr, int fq) const {
        const int row0 = u.pm * BM + wr * 64 + fr; const int col0 = u.pn * BM + wc * 32 + 8 * fq;
#pragma unroll
        for (int ai = 0; ai < 2; ++ai)
#pragma unroll
            for (int m = 0; m < 4; ++m) { bf16_t* rowp = O + (size_t)(row0 + ai * HALF + m * 16) * ldc + col0;
#pragma unroll
                for (int bj = 0; bj < 2; ++bj) { const f32x4 v0 = acc[ai][bj][m][0], v1 = acc[ai][bj][m][1];
                    u32x4 w; w.x = cvt_pk_bf16(v0[0], v0[1]); w.y = cvt_pk_bf16(v0[2], v0[3]); w.z = cvt_pk_bf16(v1[0], v1[1]); w.w = cvt_pk_bf16(v1[2], v1[3]);
                    *(u32x4*)(rowp + bj * HALF) = w; } }
    }
};

struct EpiProj {
    static constexpr bool PERM = true;
    bf16_t* O;
    __device__ __forceinline__ void operator()(const f32x4 (&acc)[2][2][4][2], const Unit& u, int wr, int wc, int fr, int fq) const {
        const int row0 = u.pm * BM + wr * 64 + fr;
#pragma unroll
        for (int bj = 0; bj < 2; ++bj) { const int c32 = u.pn * BM + bj * HALF + wc * 32;
            if (c32 >= DIN) continue;
            int ts, W = 128;
            if (c32 < AF) ts = AQ; else if (c32 < AI) ts = AF; else if (c32 < AG) ts = AI; else if (c32 < BQ) ts = AG; else if (c32 < BKC) ts = BQ; else if (c32 < BV) ts = BKC;
            else if (c32 < BG) ts = BV; else if (c32 < CQ) ts = BG; else if (c32 < CK) { ts = CQ; W = 64; } else if (c32 < CV) { ts = CK; W = 64; } else if (c32 < CG) ts = CV; else ts = CG;
            const int cp = c32 - ts, h = cp / W, d = cp % W + 8 * fq;
            bf16_t* base = O + (size_t)ts * NTOK + (size_t)h * NTOK * W + d;
#pragma unroll
            for (int ai = 0; ai < 2; ++ai)
#pragma unroll
                for (int m = 0; m < 4; ++m) { const f32x4 v0 = acc[ai][bj][m][0], v1 = acc[ai][bj][m][1];
                    u32x4 w; w.x = cvt_pk_bf16(v0[0], v0[1]); w.y = cvt_pk_bf16(v0[2], v0[3]); w.z = cvt_pk_bf16(v1[0], v1[1]); w.w = cvt_pk_bf16(v1[2], v1[3]);
                    *(u32x4*)(base + (size_t)(row0 + ai * HALF + m * 16) * W) = w; } }
    }
};

template <class Epi, class Sched>
__device__ __forceinline__ void gemm_phase(LAS unsigned char* lds, const Gemm g, const Sched& S, const Epi& E) {
    const int tid = threadIdx.x, wid = __builtin_amdgcn_readfirstlane(tid >> 6), lane = tid & 63, wr = wid >> 2, wc = wid & 3, fr = lane & 15, fq = lane >> 4;
    const int K = g.K, nt = K / BK;
    unsigned voffA[2], voffB[2];
#pragma unroll
    for (int i = 0; i < 2; ++i) { int R, C; stage_rc(tid * 16 + i * 8192, R, C); const int Rb = Epi::PERM ? ((R & ~31) + perm32(R & 31)) : R;
        voffA[i] = (unsigned)(R * K + C) * 2u; voffB[i] = (unsigned)(Rb * K + C) * 2u; }
    const size_t kstep = (size_t)(BK * 2);
    const size_t hstep = (size_t)HALF * K * 2;
    const size_t tstep = 2 * hstep;
    const unsigned ldsw = (unsigned)wid * 1024u;
    const int aoff = lds_byte(wr * 64 + fr, fq * 8), boff = lds_byte(wc * 32 + fr, fq * 8);
#define PG8_SA(b, h) (((b) * 2 + (h)) * HTB)
#define PG8_SB(b, h) ((4 + (b) * 2 + (h)) * HTB)
#define PG8_STAGE(bufoff, gbase, voff) do { _Pragma("unroll") for (int _i = 0; _i < 2; ++_i) \
        __builtin_amdgcn_global_load_lds((const unsigned*)((const char*)(gbase) + (voff)[_i]), (LAS unsigned*)(lds + (bufoff) + ldsw + _i * 8192), 16, 0, 0); } while (0)
#define PG8_LDA(dst, b, h) do { _Pragma("unroll") for (int m = 0; m < 4; ++m) _Pragma("unroll") for (int k = 0; k < 2; ++k) dst[m][k] = *(const LAS bf16x8*)(lds + PG8_SA(b, h) + aoff + m * 2048 + k * 1024); } while (0)
#define PG8_LDB(dst, b, h) do { _Pragma("unroll") for (int n = 0; n < 2; ++n) _Pragma("unroll") for (int k = 0; k < 2; ++k) dst[n][k] = *(const LAS bf16x8*)(lds + PG8_SB(b, h) + boff + n * 2048 + k * 1024); } while (0)
#define PG8_MMA(ai, bj, At, Bt) do { __builtin_amdgcn_s_setprio(1); _Pragma("unroll") for (int m = 0; m < 4; ++m) _Pragma("unroll") for (int n = 0; n < 2; ++n) _Pragma("unroll") for (int k = 0; k < 2; ++k) \
        acc[ai][bj][m][n] = __builtin_amdgcn_mfma_f32_16x16x32_bf16(Bt[n][k], At[m][k], acc[ai][bj][m][n], 0, 0, 0); __builtin_amdgcn_s_setprio(0); } while (0)
#define PG8_WAIT_V(n) asm volatile("s_waitcnt vmcnt(" #n ")" ::: "memory")
#define PG8_WAIT_L(n) asm volatile("s_waitcnt lgkmcnt(" #n ")" ::: "memory")
#define PG8_BAR __builtin_amdgcn_s_barrier()
#define PG8_SCHED __builtin_amdgcn_sched_barrier(0)
    Unit cur, nxt; int ui = 0;
    if (!S.next(0, cur)) return;
    f32x4 acc[2][2][4][2];
#pragma unroll
    for (int a = 0; a < 2; ++a)
#pragma unroll
        for (int b = 0; b < 2; ++b)
#pragma unroll
            for (int m = 0; m < 4; ++m)
#pragma unroll
                for (int n = 0; n < 2; ++n) acc[a][b][m][n] = (f32x4){0.f, 0.f, 0.f, 0.f};
    bf16x8 At[4][2], B0[2][2], B1[2][2];
    const char* cA = (const char*)g.A + (size_t)cur.pm * tstep; const char* cB = (const char*)g.Bt + (size_t)cur.pn * tstep;
    S.a_ready(cur);
    PG8_STAGE(PG8_SB(0, 0), cB, voffB); PG8_STAGE(PG8_SA(0, 0), cA, voffA); PG8_STAGE(PG8_SB(0, 1), cB + hstep, voffB); PG8_STAGE(PG8_SA(0, 1), cA + hstep, voffA);
    if (wr == 1) PG8_BAR;
    PG8_WAIT_V(4); PG8_BAR;
    PG8_STAGE(PG8_SB(1, 0), cB + kstep, voffB); PG8_STAGE(PG8_SA(1, 0), cA + kstep, voffA); PG8_STAGE(PG8_SB(1, 1), cB + hstep + kstep, voffB);
    PG8_WAIT_V(6); PG8_BAR;
    for (;;) {
        const bool has_next = S.next(ui + 1, nxt);
        const char* nA = has_next ? (const char*)g.A + (size_t)nxt.pm * tstep : cA; const char* nB = has_next ? (const char*)g.Bt + (size_t)nxt.pn * tstep : cB;
        for (int t = 0; t < nt; t += 2) {
            const bool last = (t == nt - 2);
            const char* a1 = cA + (size_t)(t + 1) * kstep;
            const char* a2 = last ? nA : cA + (size_t)(t + 2) * kstep; const char* b2 = last ? nB : cB + (size_t)(t + 2) * kstep;
            const char* a3 = a2 + kstep; const char* b3 = b2 + kstep;
            if (last && has_next) S.a_ready(nxt);
            PG8_LDB(B0, 0, 0); PG8_SCHED; PG8_LDA(At, 0, 0); PG8_STAGE(PG8_SA(1, 1), a1 + hstep, voffA);
            PG8_WAIT_L(8); PG8_BAR; PG8_WAIT_L(0); PG8_MMA(0, 0, At, B0); PG8_BAR; PG8_SCHED;
            PG8_LDB(B1, 0, 1); PG8_STAGE(PG8_SB(0, 0), b2, voffB);
            PG8_BAR; PG8_WAIT_L(0); PG8_MMA(0, 1, At, B1); PG8_BAR;
            PG8_LDA(At, 0, 1); PG8_STAGE(PG8_SA(0, 0), a2, voffA);
            PG8_BAR; PG8_WAIT_L(0); PG8_MMA(1, 0, At, B0); PG8_BAR; PG8_SCHED;
            PG8_STAGE(PG8_SB(0, 1), b2 + hstep, voffB);
            PG8_WAIT_V(6); PG8_BAR; PG8_MMA(1, 1, At, B1); PG8_BAR;
            PG8_LDB(B0, 1, 0); PG8_SCHED; PG8_LDA(At, 1, 0); PG8_STAGE(PG8_SA(0, 1), a2 + hstep, voffA);
            PG8_WAIT_L(8); PG8_BAR; PG8_WAIT_L(0); PG8_MMA(0, 0, At, B0); PG8_BAR; PG8_SCHED;
            PG8_LDB(B1, 1, 1); PG8_STAGE(PG8_SB(1, 0), b3, voffB);
            PG8_BAR; PG8_WAIT_L(0); PG8_MMA(0, 1, At, B1); PG8_BAR;
            PG8_LDA(At, 1, 1); PG8_STAGE(PG8_SA(1, 0), a3, voffA);
            PG8_BAR; PG8_WAIT_L(0); PG8_MMA(1, 0, At, B0); PG8_BAR; PG8_SCHED;
            PG8_STAGE(PG8_SB(1, 1), b3 + hstep, voffB);
            PG8_WAIT_V(6); PG8_BAR; PG8_MMA(1, 1, At, B1); PG8_BAR;
        }
        E(acc, cur, wr, wc, fr, fq); S.done(cur);
        if (!has_next) break;
#pragma unroll
        for (int a = 0; a < 2; ++a)
#pragma unroll
            for (int b = 0; b < 2; ++b)
#pragma unroll
                for (int m = 0; m < 4; ++m)
#pragma unroll
                    for (int n = 0; n < 2; ++n) acc[a][b][m][n] = (f32x4){0.f, 0.f, 0.f, 0.f};
        cur = nxt; cA = nA; cB = nB; ++ui;
    }
    PG8_WAIT_V(0);
    if (wr == 0) PG8_BAR;
    PG8_BAR;
#undef PG8_SA
#undef PG8_SB
#undef PG8_STAGE
#undef PG8_LDA
#undef PG8_LDB
#undef PG8_MMA
#undef PG8_WAIT_V
#undef PG8_WAIT_L
#undef PG8_BAR
#undef PG8_SCHED
}
}

#define LDS_WAIT() asm volatile("s_waitcnt lgkmcnt(0)" ::: "memory")
__device__ __forceinline__ void p0_transpose_item(const float* W, int K, int N, bf16_t* WT, LAS float* scr, int item, int lane, bool stream = false) {
    const int nblk = N / 32, kb = item / nblk, nb = item % nblk, k0 = 64 * kb, n0 = 32 * nb;
#pragma unroll 8
    for (int i = 0; i < 32; ++i) { const int kk = 2 * i + (lane >> 5); scr[kk * 33 + (lane & 31)] = W[(size_t)(k0 + kk) * N + n0 + (lane & 31)]; }
    LDS_WAIT(); asm volatile("" ::: "memory");
    const int c = lane & 7;
#pragma unroll
    for (int j = 0; j < 4; ++j) { const int n = (lane >> 3) + 8 * j; const LAS float* s = scr + (8 * c) * 33 + n;
        u32x4 o; o.x = cvt_pk_bf16(s[0 * 33], s[1 * 33]); o.y = cvt_pk_bf16(s[2 * 33], s[3 * 33]); o.z = cvt_pk_bf16(s[4 * 33], s[5 * 33]); o.w = cvt_pk_bf16(s[6 * 33], s[7 * 33]);
        if (stream) __builtin_nontemporal_store(o, (u32x4*)(WT + (size_t)(n0 + n) * K + k0 + 8 * c)); else *(u32x4*)(WT + (size_t)(n0 + n) * K + k0 + 8 * c) = o; }
    LDS_WAIT(); asm volatile("" ::: "memory");
}
template <bool FINAL>
__device__ __forceinline__ void norm_row(int row, const float* src, const bf16_t* d1, const bf16_t* d2, const f32x4 (&gv)[8], bf16_t* dsth, float* dstf, int lane, bf16_t* xb = nullptr) {
    const float* xr = src + (size_t)row * DM;
    f32x4 v[8]; float ss = 0.f;
#pragma unroll
    for (int j = 0; j < 8; ++j) v[j] = *(const f32x4*)(xr + 4 * (lane + 64 * j));
    if (d1) {
#pragma unroll
        for (int j = 0; j < 8; ++j) { const u32x2 a = *(const u32x2*)(d1 + (size_t)row * DM + 4 * (lane + 64 * j));
            v[j][0] += bflo(a.x); v[j][1] += bfhi(a.x); v[j][2] += bflo(a.y); v[j][3] += bfhi(a.y); } }
    if (d2) {
#pragma unroll
        for (int j = 0; j < 8; ++j) { const u32x2 a = *(const u32x2*)(d2 + (size_t)row * DM + 4 * (lane + 64 * j));
            v[j][0] += bflo(a.x); v[j][1] += bfhi(a.x); v[j][2] += bflo(a.y); v[j][3] += bfhi(a.y); } }
#pragma unroll
    for (int j = 0; j < 8; ++j) ss += (v[j][0] * v[j][0] + v[j][1] * v[j][1]) + (v[j][2] * v[j][2] + v[j][3] * v[j][3]);
    const float msq = wave_sum(ss) * (1.f / DM) + EPSN, r = rsqrtf(msq);
    if (xb && lane == 0) ((float*)xb)[row] = sqrtf(msq);
#pragma unroll
    for (int j = 0; j < 8; ++j) { const f32x4 o = v[j] * r * gv[j];
        if (FINAL) __builtin_nontemporal_store(o, (f32x4*)(dstf + (size_t)row * DM + 4 * (lane + 64 * j)));
        else { u32x2 w; w.x = cvt_pk_bf16(o[0], o[1]); w.y = cvt_pk_bf16(o[2], o[3]); *(u32x2*)(dsth + (size_t)row * DM + 4 * (lane + 64 * j)) = w; } }
}
__device__ __forceinline__ void phase_final(const bf16_t* h1, const bf16_t* d2, const float* rr, const float* g1, const float* gain, float* dst, int tid) {
    const int wave = tid >> 6, lane = tid & 63;
    f32x4 gv[8], ig[8];
#pragma unroll
    for (int j = 0; j < 8; ++j) { gv[j] = *(const f32x4*)(gain + 4 * (lane + 64 * j)); const f32x4 t = *(const f32x4*)(g1 + 4 * (lane + 64 * j));
        ig[j] = (f32x4){rcp_f(t[0]), rcp_f(t[1]), rcp_f(t[2]), rcp_f(t[3])}; }
    for (int row = blockIdx.x * 8 + wave; row < NTOK; row += gridDim.x * 8) {
        const float sc = rr[row];
        f32x4 v[8]; float ss = 0.f;
#pragma unroll
        for (int j = 0; j < 8; ++j) { const u32x2 p = *(const u32x2*)(h1 + (size_t)row * DM + 4 * (lane + 64 * j)), q = *(const u32x2*)(d2 + (size_t)row * DM + 4 * (lane + 64 * j));
            v[j][0] = bflo(p.x) * sc * ig[j][0] + bflo(q.x); v[j][1] = bfhi(p.x) * sc * ig[j][1] + bfhi(q.x); v[j][2] = bflo(p.y) * sc * ig[j][2] + bflo(q.y); v[j][3] = bfhi(p.y) * sc * ig[j][3] + bfhi(q.y);
            ss += (v[j][0] * v[j][0] + v[j][1] * v[j][1]) + (v[j][2] * v[j][2] + v[j][3] * v[j][3]); }
        const float r = rsqrtf(wave_sum(ss) * (1.f / DM) + EPSN);
#pragma unroll
        for (int j = 0; j < 8; ++j) __builtin_nontemporal_store(v[j] * r * gv[j], (f32x4*)(dst + (size_t)row * DM + 4 * (lane + 64 * j)));
    }
}
template <bool FINAL>
__device__ __forceinline__ void phase_norm(const float* src, const bf16_t* d1, const bf16_t* d2, const float* gain, bf16_t* dsth, float* dstf, int tid, bf16_t* xb = nullptr) {
    const int wave = tid >> 6, lane = tid & 63;
    f32x4 gv[8];
#pragma unroll
    for (int j = 0; j < 8; ++j) gv[j] = *(const f32x4*)(gain + 4 * (lane + 64 * j));
    for (int row = blockIdx.x * 8 + wave; row < NTOK; row += gridDim.x * 8) norm_row<FINAL>(row, src, d1, d2, gv, dsth, dstf, lane, xb);
}

__device__ __forceinline__ void phase_prep(const Params& P, LAS unsigned char* lds, int tid) {
    const int wave = tid >> 6, lane = tid & 63;
    LAS float* scr = (LAS float*)(lds + wave * 8704);
    const int gw = blockIdx.x * 8 + wave, NGW = gridDim.x * 8;
    constexpr int I_IN = (DM / 64) * (DIN / 32), I_OUT = (DM / 64) * (DM / 32);
    bf16_t* win = (bf16_t*)(P.ws + WS_WIN); bf16_t* wout = (bf16_t*)(P.ws + WS_WOUT);
    static_assert(2 * (I_IN + I_OUT) == 256 * 75 && NTOK == 256 * 128, "interleave pattern");
    f32x4 gv[8];
#pragma unroll
    for (int j = 0; j < 8; ++j) gv[j] = *(const f32x4*)(P.norm_gain + 4 * (lane + 64 * j));
    for (int u = gw; u < 256 * 203; u += NGW) {
        const int q = u / 203, rr = u % 203;
        if (rr >= 75) { norm_row<false>(q * 128 + (rr - 75), P.x, nullptr, nullptr, gv, (bf16_t*)(P.ws + WS_H), nullptr, lane); continue; }
        int r = q * 75 + rr;
        if (r < 2 * I_IN) { const int l = r / I_IN; r -= l * I_IN; p0_transpose_item(P.w_in + (size_t)l * DM * DIN, DM, DIN, win + (size_t)l * LDP * DM, scr, r, lane, l != 0); }
        else { r -= 2 * I_IN; const int l = r / I_OUT; r -= l * I_OUT; p0_transpose_item(P.w_out + (size_t)l * DM * DM, DM, DM, wout + (size_t)l * DM * DM, scr, r, lane, l != 0); }
    }
    const int gt = blockIdx.x * 512 + tid, NT = gridDim.x * 512;
    for (int i = gt; i < 2 * 32768; i += NT) { const int l = i >> 15, c = i & 32767; *(u32x4*)(win + (size_t)l * LDP * DM + (size_t)DIN * DM + (size_t)c * 8) = (u32x4){0u, 0u, 0u, 0u}; }
    float2* cs = (float2*)(P.ws + WS_CS);
    for (int i = gt; i < SEQ * 32; i += NT) { const int pos = i >> 5, f = i & 31;
        const float inv = exp2f(-(float)f * (13.287712379549449f / 31.0f));
        const float ang = (float)pos * inv;
        double rev = (double)ang * 0.15915494309189535; rev -= floor(rev);
        const float fr = (float)rev;
        cs[i] = make_float2(__builtin_amdgcn_cosf(fr), __builtin_amdgcn_sinf(fr)); }
}

constexpr int L_T0 = 0, L_T1 = 16384, L_T2 = 32768, L_T3 = 49152, L_T4 = 65536, L_AUX = 98304;

template <int DK>
__device__ __forceinline__ void ds_core(LAS unsigned char* kd, LAS unsigned char* vt, bf16_t* ST, int w, int lane) {
    const int g = lane >> 4, c15 = lane & 15;
    constexpr int NVB = (DK == 128) ? 8 : 4;
    const int kb = (DK == 128) ? w : (w & 3), vb0 = (DK == 128) ? 0 : 4 * (w >> 2);
    const unsigned ka = tr_addr<false>(lane, kb), ka1 = tr_addr_n1(lane, kb);
    bf16x8 a[2], vf[2][NVB];
#pragma unroll
    for (int ks = 0; ks < 2; ++ks) { a[ks] = tr_frag_n(kd, ka, ka1, ks);
#pragma unroll
        for (int i = 0; i < NVB; ++i) vf[ks][i] = tr_frag_n(vt, tr_addr<false>(lane, vb0 + i), tr_addr_n1(lane, vb0 + i), ks); }
    f32x4 acc[NVB];
#pragma unroll
    for (int i = 0; i < NVB; ++i) acc[i] = (f32x4){0.f, 0.f, 0.f, 0.f};
#pragma unroll
    for (int ks = 0; ks < 2; ++ks)
#pragma unroll
        for (int i = 0; i < NVB; ++i) acc[i] = mfma16(a[ks], vf[ks][i], acc[i]);
#pragma unroll
    for (int i = 0; i < NVB; ++i) { const int vb = vb0 + i;
        u32x2 o; o.x = cvt_pk_bf16(acc[i][0], acc[i][1]); o.y = cvt_pk_bf16(acc[i][2], acc[i][3]);
        *(u32x2*)(ST + (size_t)(16 * vb + c15) * DK + 16 * kb + 4 * g) = o; }
}

template <int DK, bool ISC>
__device__ __forceinline__ void out_core(LAS unsigned char* qs, LAS unsigned char* ks, LAS unsigned char* qi, LAS unsigned char* vt, LAS unsigned char* st, LAS float* red,
                                         float gl2, LAS unsigned char* gate, const float* gain, bf16_t* y, int w, int lane) {
    constexpr int KS = DK / 32;
    const int tb = w & 3, vh = w >> 2, g = lane >> 4, c15 = lane & 15, t = 16 * tb + c15;
    unsigned ra[KS];
#pragma unroll
    for (int kk = 0; kk < KS; ++kk) ra[kk] = row_addr(lane, kk);
    bf16x8 qf[KS], qif[KS];
#pragma unroll
    for (int kk = 0; kk < KS; ++kk) qf[kk] = row_frag_a(qs, ra[kk], tb);
    f32x4 accs[4];
#pragma unroll
    for (int sb = 0; sb < 4; ++sb) accs[sb] = (f32x4){0.f, 0.f, 0.f, 0.f};
    {   bf16x8 kf[2][4];
#pragma unroll
        for (int sb = 0; sb < 4; ++sb) kf[0][sb] = row_frag_a(ks, ra[0], sb);
#pragma unroll
        for (int kk = 0; kk < KS; ++kk) {
            if (kk + 1 < KS) {
#pragma unroll
                for (int sb = 0; sb < 4; ++sb) kf[(kk + 1) & 1][sb] = row_frag_a(ks, ra[kk + 1 < KS ? kk + 1 : 0], sb); }
#pragma unroll
            for (int sb = 0; sb < 4; ++sb) accs[sb] = mfma16(kf[kk & 1][sb], qf[kk], accs[sb]); } }
#pragma unroll
    for (int kk = 0; kk < KS; ++kk) qif[kk] = row_frag_a(qi, ra[kk], tb);
    unsigned va[4];
#pragma unroll
    for (int i = 0; i < 4; ++i) va[i] = tr_addr<true>(lane, vh * 4 + i);
    constexpr int NS = 2 + KS;
    bf16x8 fa[2][4];
#pragma unroll
    for (int i = 0; i < 4; ++i) fa[0][i] = tr_frag_a<true>(vt, va[i], 0);
#pragma unroll
    for (int sb = 0; sb < 4; ++sb)
#pragma unroll
        for (int r = 0; r < 4; ++r) { const int s = 16 * sb + 4 * g + r; float v = accs[sb][r];
            if (ISC) v *= exp2f(gl2 * (float)(t - s));
            accs[sb][r] = (s <= t) ? v : 0.f; }
    bf16x8 pf[2]; pf[0] = pack8(accs[0], accs[1]); pf[1] = pack8(accs[2], accs[3]);
    f32x4 acco[4]; float ss = 0.f;
#pragma unroll
    for (int i = 0; i < 4; ++i) acco[i] = (f32x4){0.f, 0.f, 0.f, 0.f};
#pragma unroll
    for (int s = 0; s < NS; ++s) {
        if (s + 1 < NS) {
#pragma unroll
            for (int i = 0; i < 4; ++i) fa[(s + 1) & 1][i] = (s + 1 < 2) ? tr_frag_a<true>(vt, va[i], 1) : row_frag_a(st, ra[(s + 1 >= 2 && s + 1 < NS) ? s - 1 : 0], vh * 4 + i); }
        const bf16x8 bop = (s < 2) ? pf[s < 2 ? s : 0] : qif[(s >= 2) ? s - 2 : 0];
#pragma unroll
        for (int i = 0; i < 4; ++i) acco[i] = mfma16(fa[s & 1][i], bop, acco[i]); }
#pragma unroll
    for (int i = 0; i < 4; ++i) ss += (acco[i][0] * acco[i][0] + acco[i][1] * acco[i][1]) + (acco[i][2] * acco[i][2] + acco[i][3] * acco[i][3]);
    ss += __shfl_xor(ss, 16); ss += __shfl_xor(ss, 32);
    if (g == 0) red[vh * 64 + t] = ss;
    u32x2 gtv[4];
#pragma unroll
    for (int i = 0; i < 4; ++i) gtv[i] = *(const LAS u32x2*)(gate + t * 256 + 2 * (16 * (vh * 4 + i) + 4 * g));
    __syncthreads();
    const float rinv = rsqrtf((red[t] + red[64 + t]) * (1.f / 128.f) + EPSN);
#pragma unroll
    for (int i = 0; i < 4; ++i) { const int v0 = 16 * (vh * 4 + i) + 4 * g;
        const u32x2 gt2 = gtv[i];
        f32x4 gn = (f32x4){1.f, 1.f, 1.f, 1.f}; if (!ISC) gn = *(const f32x4*)(gain + v0);
        const float o0 = acco[i][0] * rinv * gn[0] * silu_f(bflo(gt2.x)), o1 = acco[i][1] * rinv * gn[1] * silu_f(bfhi(gt2.x));
        const float o2 = acco[i][2] * rinv * gn[2] * silu_f(bflo(gt2.y)), o3 = acco[i][3] * rinv * gn[3] * silu_f(bfhi(gt2.y));
        u32x2 o; o.x = cvt_pk_bf16(o0, o1); o.y = cvt_pk_bf16(o2, o3);
        *(u32x2*)(y + (size_t)t * DM + v0) = o; }
}

__device__ __forceinline__ float lb_of(const Params& P, int layer, int k) {
    if (layer == 0) return 0.f;
    const float l0 = P.lb_logits[k], l1 = P.lb_logits[768 + k];
    return rcp_f(1.f + __expf(l0 - l1));
}

constexpr int R_Z = 0, R_Q = 16384, R_2 = 32768, R_V = 49152, R_ST = 65536, R_G = 98304, R_AUX = 131072;
__device__ __forceinline__ void raw_put(LAS unsigned char* reg, int i, u32x4 v) { *(LAS u32x4*)(reg + (i >> 4) * 256 + (i & 15) * 16) = v; }
__device__ __forceinline__ void swz_put(LAS unsigned char* reg, int i, u32x4 v) { *(LAS u32x4*)(reg + off_b((unsigned)(i >> 4), (unsigned)(i & 15))) = v; }
__device__ __forceinline__ float raw_get(LAS unsigned char* reg, int row, int col) { return bf2f(*(const LAS bf16_t*)(reg + row * 256 + 2 * col)); }

struct A1Regs { u32x4 z[2], v[2]; };
__device__ __forceinline__ void a1_load(A1Regs& R, const Params& P, int item, int tid) {
    const int cidx = item / 6, h = item % 6; const bf16_t* proj = (const bf16_t*)(P.ws + WS_PROJ);
#pragma unroll
    for (int u = 0; u < 2; ++u) { const int i = tid + 512 * u; const size_t o = (size_t)(cidx * 64 + (i >> 4)) * 128 + (i & 15) * 8;
        R.z[u] = *(const u32x4*)(pjp(proj, AF, 128, h, 0) + o); R.v[u] = *(const u32x4*)(pjp(proj, AI, 128, h, 0) + o); }
}
__device__ __forceinline__ void a1_phase(const Params& P, int layer, LAS unsigned char* lds, int tid) {
    const int w = tid >> 6, lane = tid & 63, kp = tid & 63, G = gridDim.x;
    LAS float* part = (LAS float*)(lds + R_AUX);
    A1Regs R; int it = blockIdx.x; if (it < 3072) a1_load(R, P, it, tid);
    for (; it < 3072; it += G) {
        const int cidx = it / 6, h = it % 6;
        const float lb0 = lb_of(P, layer, h * 128 + 2 * kp), lb1 = lb_of(P, layer, h * 128 + 2 * kp + 1), om0 = 1.f - lb0, om1 = 1.f - lb1;
#pragma unroll
        for (int u = 0; u < 2; ++u) { raw_put(lds + R_Q, tid + 512 * u, R.z[u]); swz_put(lds + R_V, tid + 512 * u, R.v[u]); }
        __syncthreads();
        if (it + G < 3072) a1_load(R, P, it + G, tid);
        float f0[8], f1[8]; float t0 = 1.f, t1 = 1.f;
#pragma unroll
        for (int i = 0; i < 8; ++i) { const unsigned zz = *(const LAS unsigned*)(lds + R_Q + (8 * w + i) * 256 + 4 * kp);
            f0[i] = lb0 + om0 * rcp_f(1.f + __expf(-bflo(zz))); f1[i] = lb1 + om1 * rcp_f(1.f + __expf(-bfhi(zz))); t0 *= f0[i]; t1 *= f1[i]; }
        *(LAS f32x2*)(part + w * 128 + 2 * kp) = (f32x2){t0, t1};
        __syncthreads();
        float s0 = 1.f, s1 = 1.f, p0 = 1.f, p1 = 1.f;
#pragma unroll
        for (int g2 = 0; g2 < 8; ++g2) { const f32x2 tv = *(const LAS f32x2*)(part + g2 * 128 + 2 * kp); p0 *= tv[0]; p1 *= tv[1]; if (g2 > w) { s0 *= tv[0]; s1 *= tv[1]; } }
#pragma unroll
        for (int i = 7; i >= 0; --i) { const int row = 8 * w + i;
            *(LAS unsigned*)(lds + R_Z + off_b((unsigned)row, (unsigned)(kp >> 2)) + 4 * (kp & 3)) = cvt_pk_bf16((1.f - f0[i]) * s0, (1.f - f1[i]) * s1);
            s0 *= f0[i]; s1 *= f1[i]; }
        if (w == 0) *(f32x2*)((float*)(P.ws + WS_DEC) + (size_t)(cidx * 6 + h) * 128 + 2 * kp) = (f32x2){p0, p1};
        __syncthreads();
        ds_core<128>(lds + R_Z, lds + R_V, (bf16_t*)(P.ws + WS_STA) + (size_t)(cidx * 6 + h) * 16384, w, lane);
        __syncthreads();
    }
}
struct A3Regs { u32x4 z[2], q[2], v[2], g[2], st[4]; };
__device__ __forceinline__ void a3_load(A3Regs& R, const Params& P, int item, int tid) {
    const int cidx = item / 6, h = item % 6; const bf16_t* proj = (const bf16_t*)(P.ws + WS_PROJ);
#pragma unroll
    for (int u = 0; u < 2; ++u) { const int i = tid + 512 * u; const size_t o = (size_t)(cidx * 64 + (i >> 4)) * 128 + (i & 15) * 8;
        R.z[u] = *(const u32x4*)(pjp(proj, AF, 128, h, 0) + o); R.q[u] = *(const u32x4*)(pjp(proj, AQ, 128, h, 0) + o); R.v[u] = *(const u32x4*)(pjp(proj, AI, 128, h, 0) + o); R.g[u] = *(const u32x4*)(pjp(proj, AG, 128, h, 0) + o); }
    const bf16_t* st = (const bf16_t*)(P.ws + WS_STA) + (size_t)(cidx * 6 + h) * 16384;
#pragma unroll
    for (int u = 0; u < 4; ++u) R.st[u] = *(const u32x4*)(st + (size_t)(tid + 512 * u) * 8);
}
__device__ __forceinline__ void a3_phase(const Params& P, int layer, LAS unsigned char* lds, int tid) {
    const int w = tid >> 6, lane = tid & 63, kp = tid & 63, G = gridDim.x;
    LAS float* part = (LAS float*)(lds + R_AUX);
    A3Regs R; int it = blockIdx.x; if (it < 3072) a3_load(R, P, it, tid);
    for (; it < 3072; it += G) {
        const int cidx = it / 6, h = it % 6, tok0 = cidx * 64;
        const float lb0 = lb_of(P, layer, h * 128 + 2 * kp), lb1 = lb_of(P, layer, h * 128 + 2 * kp + 1), om0 = 1.f - lb0, om1 = 1.f - lb1;
#pragma unroll
        for (int u = 0; u < 2; ++u) { const int i = tid + 512 * u; raw_put(lds + R_Z, i, R.z[u]); raw_put(lds + R_Q, i, R.q[u]); swz_put(lds + R_V, i, R.v[u]); raw_put(lds + R_G, i, R.g[u]); }
#pragma unroll
        for (int u = 0; u < 4; ++u) swz_put(lds + R_ST, tid + 512 * u, R.st[u]);
        __syncthreads();
        if (it + G < 3072) a3_load(R, P, it + G, tid);
        float f0[8], f1[8], q0[8], q1[8]; float t0 = 1.f, t1 = 1.f;
#pragma unroll
        for (int i = 0; i < 8; ++i) { const unsigned zz = *(const LAS unsigned*)(lds + R_Z + (8 * w + i) * 256 + 4 * kp), qq = *(const LAS unsigned*)(lds + R_Q + (8 * w + i) * 256 + 4 * kp);
            f0[i] = lb0 + om0 * rcp_f(1.f + __expf(-bflo(zz))); f1[i] = lb1 + om1 * rcp_f(1.f + __expf(-bfhi(zz))); t0 *= f0[i]; t1 *= f1[i];
            q0[i] = silu_f(bflo(qq)) * 0.08838834764831845f; q1[i] = silu_f(bfhi(qq)) * 0.08838834764831845f; }
        *(LAS f32x2*)(part + w * 128 + 2 * kp) = (f32x2){t0, t1};
        __syncthreads();
        float p0 = 1.f, p1 = 1.f, x0 = 1.f, x1 = 1.f;
#pragma unroll
        for (int g2 = 0; g2 < 8; ++g2) { const f32x2 tv = *(const LAS f32x2*)(part + g2 * 128 + 2 * kp);
            if (g2 < w) { p0 *= tv[0]; p1 *= tv[1]; }
            if ((w < 4) ? (g2 > w && g2 < 4) : (g2 >= 4 && g2 < w)) { x0 *= tv[0]; x1 *= tv[1]; } }
#define A3_PUT(REG, ROW, VA, VB) *(LAS unsigned*)(lds + (REG) + off_b((unsigned)(ROW), (unsigned)(kp >> 2)) + 4 * (kp & 3)) = cvt_pk_bf16((VA), (VB))
        if (w >= 4) {
#pragma unroll
            for (int i = 0; i < 8; ++i) { const int row = 8 * w + i; p0 *= f0[i]; p1 *= f1[i]; x0 *= f0[i]; x1 *= f1[i];
                A3_PUT(R_2, row, q0[i] * p0, q1[i] * p1);
                A3_PUT(R_Z, row, q0[i] * x0, q1[i] * x1);
                A3_PUT(R_Q, row, (1.f - f0[i]) * rcp_f(fmaxf(x0, 1e-35f)), (1.f - f1[i]) * rcp_f(fmaxf(x1, 1e-35f))); }
        } else {
#pragma unroll
            for (int i = 0; i < 8; ++i) { p0 *= f0[i]; p1 *= f1[i]; A3_PUT(R_2, 8 * w + i, q0[i] * p0, q1[i] * p1); }
#pragma unroll
            for (int i = 7; i >= 0; --i) { const int row = 8 * w + i;
                A3_PUT(R_Z, row, q0[i] * rcp_f(fmaxf(x0, 1e-35f)), q1[i] * rcp_f(fmaxf(x1, 1e-35f)));
                A3_PUT(R_Q, row, (1.f - f0[i]) * x0, (1.f - f1[i]) * x1);
                x0 *= f0[i]; x1 *= f1[i]; }
        }
#undef A3_PUT
        __syncthreads();
        out_core<128, false>(lds + R_Z, lds + R_Q, lds + R_2, lds + R_V, lds + R_ST, part + 1024, 0.f,
                             lds + R_G, P.hg_gain + layer * 128, (bf16_t*)(P.ws + (layer == 0 ? WS_H : WS_D1)) + (size_t)tok0 * DM + YA + h * 128, w, lane);
    }
}
__device__ __forceinline__ float c_gl2(int h) { return log2f(1.f - exp2f(-5.f - (float)h)); }
struct C1Regs { u32x4 kq, v[2]; f32x4 cs[2]; };
__device__ __forceinline__ void c_load_cs(f32x4 (&csr)[2], const Params& P, int n, int tid) {
    const float* cs = (const float*)(P.ws + WS_CS);
#pragma unroll
    for (int u = 0; u < 2; ++u) csr[u] = *(const f32x4*)(cs + ((size_t)(n * 64 + (tid >> 4) + 32 * u) * 32 + 2 * (tid & 15)) * 2);
}
#define C_PUT(REG, ROW, COL, VA, VB) *(LAS unsigned*)(lds + (REG) + off_b((unsigned)(ROW), (unsigned)((COL) >> 3)) + 2 * ((COL) & 7)) = cvt_pk_bf16((VA), (VB))
__device__ __forceinline__ void c1_load(C1Regs& R, const Params& P, int item, int tid) {
    const int cidx = item / 5, h = item % 5, n = cidx & 255; const bf16_t* proj = (const bf16_t*)(P.ws + WS_PROJ);
    R.kq = *(const u32x4*)(pjp(proj, CK, 64, h, cidx * 64 + (tid >> 3)) + (tid & 7) * 8);
#pragma unroll
    for (int u = 0; u < 2; ++u) { const int i = tid + 512 * u; R.v[u] = *(const u32x4*)(pjp(proj, CV, 128, h, cidx * 64 + (i >> 4)) + (i & 15) * 8); }
    c_load_cs(R.cs, P, n, tid);
}
__device__ __forceinline__ void c1_phase(const Params& P, LAS unsigned char* lds, int tid) {
    const int w = tid >> 6, lane = tid & 63, ip = tid & 15, i0 = 2 * ip, r0 = tid >> 4, G = gridDim.x;
    C1Regs R; int it = blockIdx.x; if (it < 2560) c1_load(R, P, it, tid);
    for (; it < 2560; it += G) {
        const int cidx = it / 5, h = it % 5; const float gl2 = c_gl2(h);
        *(LAS u32x4*)(lds + R_Q + (tid >> 3) * 256 + (tid & 7) * 16) = R.kq;
#pragma unroll
        for (int u = 0; u < 2; ++u) swz_put(lds + R_V, tid + 512 * u, R.v[u]);
        f32x4 cs[2];
#pragma unroll
        for (int u = 0; u < 2; ++u) cs[u] = R.cs[u];
        __syncthreads();
        if (it + G < 2560) c1_load(R, P, it + G, tid);
#pragma unroll
        for (int u = 0; u < 2; ++u) { const int j = r0 + 32 * u; const f32x4 c = cs[u];
            const unsigned klo = *(const LAS unsigned*)(lds + R_Q + j * 256 + 4 * ip), khi = *(const LAS unsigned*)(lds + R_Q + j * 256 + 64 + 4 * ip);
            const float sc = 0.125f * exp2f(gl2 * (float)(63 - j));
            const float a1 = bflo(klo), a2 = bflo(khi), b1 = bfhi(klo), b2 = bfhi(khi);
            C_PUT(R_Z, j, i0, (a1 * c[0] - a2 * c[1]) * sc, (b1 * c[2] - b2 * c[3]) * sc);
            C_PUT(R_Z, j, 32 + i0, (a1 * c[1] + a2 * c[0]) * sc, (b1 * c[3] + b2 * c[2]) * sc); }
        __syncthreads();
        ds_core<64>(lds + R_Z, lds + R_V, (bf16_t*)(P.ws + WS_STC) + (size_t)(cidx * 5 + h) * 8192, w, lane);
        __syncthreads();
    }
}
struct C3Regs { u32x4 q, kk, v[2], g[2], st[2]; f32x4 cs[2]; };
__device__ __forceinline__ void c3_load(C3Regs& R, const Params& P, int item, int tid) {
    const int cidx = item / 5, h = item % 5, n = cidx & 255; const bf16_t* proj = (const bf16_t*)(P.ws + WS_PROJ);
    { const size_t o = (size_t)(cidx * 64 + (tid >> 3)) * 64 + (tid & 7) * 8; R.q = *(const u32x4*)(pjp(proj, CQ, 64, h, 0) + o); R.kk = *(const u32x4*)(pjp(proj, CK, 64, h, 0) + o); }
#pragma unroll
    for (int u = 0; u < 2; ++u) { const int i = tid + 512 * u; const size_t o = (size_t)(cidx * 64 + (i >> 4)) * 128 + (i & 15) * 8;
        R.v[u] = *(const u32x4*)(pjp(proj, CV, 128, h, 0) + o); R.g[u] = *(const u32x4*)(pjp(proj, CG, 128, h, 0) + o); }
    const bf16_t* st = (const bf16_t*)(P.ws + WS_STC) + (size_t)(cidx * 5 + h) * 8192;
#pragma unroll
    for (int u = 0; u < 2; ++u) R.st[u] = *(const u32x4*)(st + (size_t)(tid + 512 * u) * 8);
    c_load_cs(R.cs, P, n, tid);
}
__device__ __forceinline__ void c3_phase(const Params& P, int layer, LAS unsigned char* lds, int tid) {
    const int w = tid >> 6, lane = tid & 63, ip = tid & 15, i0 = 2 * ip, r0 = tid >> 4, G = gridDim.x;
    C3Regs R; int it = blockIdx.x; if (it < 2560) c3_load(R, P, it, tid);
    for (; it < 2560; it += G) {
        const int cidx = it / 5, h = it % 5, tok0 = cidx * 64; const float gl2 = c_gl2(h);
        *(LAS u32x4*)(lds + R_G + 16384 + (tid >> 3) * 256 + (tid & 7) * 16) = R.q;
        *(LAS u32x4*)(lds + R_G + 16384 + (tid >> 3) * 256 + 128 + (tid & 7) * 16) = R.kk;
#pragma unroll
        for (int u = 0; u < 2; ++u) { const int c = tid + 512 * u; swz_put(lds + R_V, c, R.v[u]); raw_put(lds + R_G, c, R.g[u]);
            *(LAS u32x4*)(lds + R_ST + off_b((unsigned)(c >> 3), (unsigned)(c & 7))) = R.st[u]; }
        f32x4 cs[2];
#pragma unroll
        for (int u = 0; u < 2; ++u) cs[u] = R.cs[u];
        __syncthreads();
        if (it + G < 2560) c3_load(R, P, it + G, tid);
        LAS unsigned char* rqk = lds + R_G + 16384;
#pragma unroll
        for (int u = 0; u < 2; ++u) { const int j = r0 + 32 * u; const f32x4 c = cs[u];
            const unsigned qlo = *(const LAS unsigned*)(rqk + j * 256 + 4 * ip), qhi = *(const LAS unsigned*)(rqk + j * 256 + 64 + 4 * ip);
            const unsigned klo = *(const LAS unsigned*)(rqk + j * 256 + 128 + 4 * ip), khi = *(const LAS unsigned*)(rqk + j * 256 + 192 + 4 * ip);
            const float dq = exp2f(gl2 * (float)(j + 1));
            const float qa0 = bflo(qlo) * c[0] - bflo(qhi) * c[1], qb0 = bflo(qlo) * c[1] + bflo(qhi) * c[0];
            const float qa1 = bfhi(qlo) * c[2] - bfhi(qhi) * c[3], qb1 = bfhi(qlo) * c[3] + bfhi(qhi) * c[2];
            C_PUT(R_Z, j, i0, qa0, qa1); C_PUT(R_Z, j, 32 + i0, qb0, qb1);
            C_PUT(R_2, j, i0, qa0 * dq, qa1 * dq); C_PUT(R_2, j, 32 + i0, qb0 * dq, qb1 * dq);
            C_PUT(R_Q, j, i0, (bflo(klo) * c[0] - bflo(khi) * c[1]) * 0.125f, (bfhi(klo) * c[2] - bfhi(khi) * c[3]) * 0.125f);
            C_PUT(R_Q, j, 32 + i0, (bflo(klo) * c[1] + bflo(khi) * c[0]) * 0.125f, (bfhi(klo) * c[3] + bfhi(khi) * c[2]) * 0.125f); }
        __syncthreads();
        out_core<64, true>(lds + R_Z, lds + R_Q, lds + R_2, lds + R_V, lds + R_ST, (LAS float*)(lds + R_AUX) + 512, gl2,
                           lds + R_G, nullptr, (bf16_t*)(P.ws + (layer == 0 ? WS_H : WS_D1)) + (size_t)tok0 * DM + YC + h * 128, w, lane);
    }
}
#undef C_PUT

__device__ __forceinline__ void b_item(const Params& P, int layer, LAS unsigned char* lds, int item, int tid) {
    const int b = item / 320, rem = item % 320, h = rem / 64, m = rem % 64, w = tid >> 6, lane = tid & 63;
    const int qc = w >> 1, th = w & 1, g = lane >> 4, c15 = lane & 15;
    const bf16_t* proj = (const bf16_t*)(P.ws + WS_PROJ);
    const size_t tok0 = (size_t)b * SEQ + (size_t)m * 256;
    LAS unsigned char* Qt = lds + 0; LAS unsigned char* KV = lds + 65536; LAS float* bias = (LAS float*)(lds + 131072);
    tile_load<256, 16>(Qt, pjp(proj, BQ, 128, h, tok0), 128, tid);
    for (int i = tid; i < 257; i += 512) bias[i] = P.rel_bias[(size_t)(layer * 5 + h) * 257 + i];
    const int jst = (8 - 4 * m) > 0 ? (8 - 4 * m) : 0;
    const long krow = (long)b * SEQ + (long)(4 * m - 8) * 64;
    const bf16_t* kbase = pjp(proj, BKC, 128, h, 0) + krow * 128; const bf16_t* vbase = pjp(proj, BV, 128, h, 0) + krow * 128;
    unsigned soff[2];
#pragma unroll
    for (int u = 0; u < 2; ++u) { const unsigned i = tid + 512 * u, row = i >> 4, ch = (i & 15) ^ (((row & 3u) << 2) | ((row >> 2) & 3u)); soff[u] = row * 128 + ch * 8; }
    const unsigned ldsw = (unsigned)__builtin_amdgcn_readfirstlane(w) * 1024u;
#define B_DMA(J, BUF) do { const long jo_ = (long)(J) * 64 * 128; _Pragma("unroll") for (int u = 0; u < 2; ++u) { \
        __builtin_amdgcn_global_load_lds((const unsigned*)(kbase + jo_ + soff[u]), (LAS unsigned*)(KV + (BUF) * 32768 + ldsw + u * 8192), 16, 0, 0); \
        __builtin_amdgcn_global_load_lds((const unsigned*)(vbase + jo_ + soff[u]), (LAS unsigned*)(KV + (BUF) * 32768 + 16384 + ldsw + u * 8192), 16, 0, 0); } } while (0)
    B_DMA(jst, 0);
    __syncthreads();
    LAS unsigned char* Qw = Qt + 4096 * (qc * 4 + th * 2);
    float mrun[2] = {-1e30f, -1e30f}, lrun[2] = {0.f, 0.f}; const float bfar = bias[256];
    unsigned kaddr[4], vaddr[8];
#pragma unroll
    for (int kk = 0; kk < 4; ++kk) kaddr[kk] = row_addr(lane, kk);
#pragma unroll
    for (int vb = 0; vb < 8; ++vb) vaddr[vb] = tr_addr<true>(lane, vb);
    f32x4 acco[2][8];
#pragma unroll
    for (int u = 0; u < 2; ++u)
#pragma unroll
        for (int i = 0; i < 8; ++i) acco[u][i] = (f32x4){0.f, 0.f, 0.f, 0.f};
    auto step = [&](int j, LAS unsigned char* Kt, LAS unsigned char* Vt) {
        const bool active = (j >= qc) && (j <= qc + 8);
        if (active) {
            const int dl = 64 * (8 + qc - j);
            f32x4 accs[2][4];
#pragma unroll
            for (int sb = 0; sb < 4; ++sb) { accs[0][sb] = (f32x4){0.f, 0.f, 0.f, 0.f}; accs[1][sb] = (f32x4){0.f, 0.f, 0.f, 0.f}; }
            __builtin_amdgcn_s_setprio(1);
#pragma unroll
            for (int kk = 0; kk < 4; ++kk) { const bf16x8 q0 = row_frag_a(Qw, kaddr[kk], 0), q1 = row_frag_a(Qw, kaddr[kk], 1);
#pragma unroll
                for (int sb = 0; sb < 4; ++sb) { const bf16x8 kf = row_frag_a(Kt, kaddr[kk], sb);
                    accs[0][sb] = mfma16(kf, q0, accs[0][sb]); accs[1][sb] = mfma16(kf, q1, accs[1][sb]); } }
            __builtin_amdgcn_s_setprio(0);
            bf16x8 pf[2][2]; float alpha[2];
#pragma unroll
            for (int u = 0; u < 2; ++u) { const int t = 32 * th + 16 * u + c15; float mt = -1e30f;
#pragma unroll
                for (int sb = 0; sb < 4; ++sb) {
                    if (dl >= 192) {
#pragma unroll
                        for (int r = 0; r < 4; ++r) { const float xv = accs[u][sb][r] * 0.08838834764831845f + bfar; accs[u][sb][r] = xv; mt = fmaxf(mt, xv); }
                    } else {
#pragma unroll
                        for (int r = 0; r < 4; ++r) { const int s = 16 * sb + 4 * g + r; int rel = t - s + dl; rel = rel > 128 ? 128 : rel;
                            const float xv = accs[u][sb][r] * 0.08838834764831845f + bias[rel + 128]; accs[u][sb][r] = xv; mt = fmaxf(mt, xv); } } }
                mt = fmaxf(mt, __shfl_xor(mt, 16)); mt = fmaxf(mt, __shfl_xor(mt, 32));
                const float mn = fmaxf(mrun[u], mt); alpha[u] = __expf(mrun[u] - mn); mrun[u] = mn;
                float ls = 0.f;
#pragma unroll
                for (int sb = 0; sb < 4; ++sb)
#pragma unroll
                    for (int r = 0; r < 4; ++r) { const float pe = __expf(accs[u][sb][r] - mn); accs[u][sb][r] = pe; ls += pe; }
                lrun[u] = lrun[u] * alpha[u] + ls;
                pf[u][0] = pack8(accs[u][0], accs[u][1]); pf[u][1] = pack8(accs[u][2], accs[u][3]); }
            __builtin_amdgcn_s_setprio(1);
#pragma unroll
            for (int vb = 0; vb < 8; ++vb) { acco[0][vb] = acco[0][vb] * alpha[0]; acco[1][vb] = acco[1][vb] * alpha[1];
#pragma unroll
                for (int ks = 0; ks < 2; ++ks) { const bf16x8 vf = tr_frag_a<true>(Vt, vaddr[vb], ks);
                    acco[0][vb] = mfma16(vf, pf[0][ks], acco[0][vb]); acco[1][vb] = mfma16(vf, pf[1][ks], acco[1][vb]); } }
            __builtin_amdgcn_s_setprio(0);
        }
    };
#pragma unroll 1
    for (int j = jst; j < 12; ++j) {
        const int buf = (j - jst) & 1;
        asm volatile("s_waitcnt vmcnt(0)" ::: "memory");
        __syncthreads();
        if (j + 1 < 12) B_DMA(j + 1, buf ^ 1);
        step(j, KV + buf * 32768, KV + buf * 32768 + 16384);
    }
    __syncthreads();
#undef B_DMA
#pragma unroll
    for (int u = 0; u < 2; ++u) {
        float l = lrun[u]; l += __shfl_xor(l, 16); l += __shfl_xor(l, 32);
        const float inv = rcp_f(l);
        const size_t tok = tok0 + 64 * qc + 32 * th + 16 * u + c15;
        const bf16_t* gate = pjp(proj, BG, 128, h, tok);
        bf16_t* y = (bf16_t*)(P.ws + (layer == 0 ? WS_H : WS_D1)) + tok * DM + YB + h * 128;
#pragma unroll
        for (int vb = 0; vb < 8; ++vb) { const int v0 = 16 * vb + 4 * g; const u32x2 gt2 = *(const u32x2*)(gate + v0);
            u32x2 o; o.x = cvt_pk_bf16(acco[u][vb][0] * inv * silu_f(bflo(gt2.x)), acco[u][vb][1] * inv * silu_f(bfhi(gt2.x)));
            o.y = cvt_pk_bf16(acco[u][vb][2] * inv * silu_f(bflo(gt2.y)), acco[u][vb][3] * inv * silu_f(bfhi(gt2.y)));
            *(u32x2*)(y + v0) = o; }
    }
}

__device__ __forceinline__ void phase_scan(const Params& P, int tid) {
    const int gt = blockIdx.x * 512 + tid, NT = gridDim.x * 512;
    for (int idx = gt; idx < 49152 + 20480; idx += NT) {
        if (idx < 49152) {
            const int bh = idx >> 12, e = (idx & 4095) * 4, b = bh / 6, h = bh % 6, k = e & 127;
            bf16_t* sp = (bf16_t*)(P.ws + WS_STA) + (size_t)(b * 256 * 6 + h) * 16384 + e;
            const float* dp = (const float*)(P.ws + WS_DEC) + (size_t)(b * 256 * 6 + h) * 128 + k;
            f32x4 S = (f32x4){0.f, 0.f, 0.f, 0.f};
            for (int n0 = 0; n0 < 256; n0 += 16) {
                u32x2 d[16]; f32x4 dc[16];
#pragma unroll
                for (int j = 0; j < 16; ++j) { d[j] = *(const u32x2*)(sp + (size_t)(n0 + j) * (6 * 16384)); dc[j] = *(const f32x4*)(dp + (size_t)(n0 + j) * 768); }
#pragma unroll
                for (int j = 0; j < 16; ++j) { u32x2 o; o.x = cvt_pk_bf16(S[0], S[1]); o.y = cvt_pk_bf16(S[2], S[3]);
                    S[0] = dc[j][0] * S[0] + bflo(d[j].x); S[1] = dc[j][1] * S[1] + bfhi(d[j].x); S[2] = dc[j][2] * S[2] + bflo(d[j].y); S[3] = dc[j][3] * S[3] + bfhi(d[j].y);
                    *(u32x2*)(sp + (size_t)(n0 + j) * (6 * 16384)) = o; }
            }
        } else {
            const int i2 = idx - 49152, bh = i2 >> 11, e = (i2 & 2047) * 4, b = bh / 5, h = bh % 5;
            bf16_t* sp = (bf16_t*)(P.ws + WS_STC) + (size_t)(b * 256 * 5 + h) * 8192 + e;
            const float cd = exp2f(64.f * c_gl2(h));
            f32x4 S = (f32x4){0.f, 0.f, 0.f, 0.f};
            for (int n0 = 0; n0 < 256; n0 += 16) {
                u32x2 d[16];
#pragma unroll
                for (int j = 0; j < 16; ++j) d[j] = *(const u32x2*)(sp + (size_t)(n0 + j) * (5 * 8192));
#pragma unroll
                for (int j = 0; j < 16; ++j) { u32x2 o; o.x = cvt_pk_bf16(S[0], S[1]); o.y = cvt_pk_bf16(S[2], S[3]);
                    S[0] = cd * S[0] + bflo(d[j].x); S[1] = cd * S[1] + bfhi(d[j].x); S[2] = cd * S[2] + bflo(d[j].y); S[3] = cd * S[3] + bfhi(d[j].y);
                    *(u32x2*)(sp + (size_t)(n0 + j) * (5 * 8192)) = o; }
            }
        }
    }
}

#define XB_TMO      128
#define XB_XCNT(j)  (256  + 64 * (j))
#define XB_XSUB(j)  (1280 + 64 * (j))
#define XB_XGEN(j)  (2304 + 64 * (j))
#define XB_TOP      3328
#define XB_TOPGEN   3392
#define XCD_BAR_WORDS 3456
#define XB_SPIN_CAP (1u << 18)

__device__ __forceinline__ unsigned xb_ld(unsigned* p)              { return __hip_atomic_load(p, __ATOMIC_RELAXED, __HIP_MEMORY_SCOPE_AGENT); }
__device__ __forceinline__ unsigned xb_add(unsigned* p, unsigned v) { return __hip_atomic_fetch_add(p, v, __ATOMIC_RELAXED, __HIP_MEMORY_SCOPE_AGENT); }
__device__ __forceinline__ unsigned xb_xcc_id() { return (unsigned)__builtin_amdgcn_s_getreg((3 << 11) | 20) & 0xFu; }
#define XB_SPIN(cond, bar) do { unsigned _sp = 0; while (cond) { __builtin_amdgcn_s_sleep(1); \
    if ((++_sp & 255u) == 0u) { if (xb_ld(&(bar)[XB_TMO])) break; if (_sp > XB_SPIN_CAP) { atomicAdd(&(bar)[XB_TMO], 1u); break; } } } } while (0)

struct XcdBarrier {
    unsigned* bar; unsigned x;
    volatile LAS unsigned* st;
};

__device__ __forceinline__ XcdBarrier xcd_barrier_post(unsigned* bar, volatile LAS unsigned* st) {
    XcdBarrier b; b.bar = bar; b.x = xb_xcc_id(); b.st = st;
    if (threadIdx.x == 0) (void)xb_add(&bar[XB_XCNT(b.x)], 1u);
    return b;
}
__device__ __forceinline__ void xcd_barrier_complete(unsigned* bar, unsigned x, unsigned& nloc, unsigned& nx) {
    const unsigned G = gridDim.x * gridDim.y * gridDim.z;
    unsigned sum, cnt, mine, sp = 0u;
    for (;;) {
        sum = 0u; cnt = 0u; mine = 0u;
#pragma unroll
        for (unsigned j = 0; j < 16; ++j) { const unsigned c = xb_ld(&bar[XB_XCNT(j)]); sum += c; cnt += (c > 0u) ? 1u : 0u; mine = (j == x) ? c : mine; }
        if (sum == G) break;
        __builtin_amdgcn_s_sleep(1);
        if ((++sp & 255u) == 0u) { if (xb_ld(&bar[XB_TMO])) break; if (sp > XB_SPIN_CAP) { atomicAdd(&bar[XB_TMO], 1u); break; } }
    }
    nloc = mine > 0u ? mine : 1u; nx = cnt > 0u ? cnt : 1u;
}

__device__ __forceinline__ void xcd_barrier(const XcdBarrier& b) {
    asm volatile("s_waitcnt vmcnt(0)" ::: "memory");
    __syncthreads();
    if (threadIdx.x == 0) {
        unsigned* bar = b.bar;
        __builtin_amdgcn_s_waitcnt(0);
        unsigned nloc = b.st[0], nx = b.st[1];
        if (nloc == 0u) { xcd_barrier_complete(bar, b.x, nloc, nx); b.st[0] = nloc; b.st[1] = nx; }
        const unsigned old = xb_add(&bar[XB_XSUB(b.x)], 1u);
        const unsigned gen = old / nloc;
        if (old + 1u == (gen + 1u) * nloc) {
            __builtin_amdgcn_fence(__ATOMIC_RELEASE, "agent");
            asm volatile("s_waitcnt vmcnt(0)" ::: "memory");
            const unsigned og = xb_add(&bar[XB_TOP], 1u);
            const unsigned tg = og / nx;
            if (og + 1u == (tg + 1u) * nx) xb_add(&bar[XB_TOPGEN], 1u);
            else XB_SPIN(xb_ld(&bar[XB_TOPGEN]) == tg, bar);
            __builtin_amdgcn_fence(__ATOMIC_ACQUIRE, "agent");
            xb_add(&bar[XB_XGEN(b.x)], 1u);
            asm volatile("s_waitcnt vmcnt(0)" ::: "memory");
        } else {
            XB_SPIN(xb_ld(&bar[XB_XGEN(b.x)]) == gen, bar);
            __builtin_amdgcn_fence(__ATOMIC_ACQUIRE, "agent");
            asm volatile("s_waitcnt vmcnt(0)" ::: "memory");
        }
    }
    __syncthreads();
}

__global__ __launch_bounds__(512, 2) void hybrid_fwd(Params P0) {
    extern __shared__ __attribute__((aligned(16))) unsigned char shm[];
    LAS unsigned char* lds = (LAS unsigned char*)shm;
    cg::grid_group grid = cg::this_grid();
    volatile LAS unsigned* xst = (volatile LAS unsigned*)(lds + 139248);
    if (threadIdx.x == 0) { xst[0] = 0u; xst[1] = 0u; }
    __syncthreads();
    XcdBarrier xb = xcd_barrier_post((unsigned*)(P0.ws + WS_END), xst);
    for (int ph = P0.ph_lo; ph < P0.ph_hi; ++ph) {
        if (ph > P0.ph_lo) { if (P0.ph_lo < 0) grid.sync();   xcd_barrier(xb); }
        Params P = P0; int tid = threadIdx.x;
        { size_t z0 = 0, z1 = 0, z2 = 0; asm volatile("" : "+s"(z0), "+s"(z1), "+s"(z2), "+v"(tid));
          P.ws = P0.ws + z0; P.out = P0.out + z1; P.x = P0.x + z2; P.w_in = P0.w_in + z0; P.norm_gain = P0.norm_gain + z1; P.lb_logits = P0.lb_logits + z2;
          P.hg_gain = P0.hg_gain + z0; P.rel_bias = P0.rel_bias + z1; P.w_out = P0.w_out + z2; P.final_gain = P0.final_gain + z0; }
        if (ph == 0) { phase_prep(P, lds, tid); continue; }
        const int layer = (ph - 1) / 6, sub = (ph - 1) % 6;
        {
        if (sub == 0) {
            pg8::Gemm gm{(const bf16_t*)(P.ws + WS_H), (const bf16_t*)(P.ws + WS_WIN) + (size_t)layer * LDP * DM, NTOK, LDP, DM};
            pg8::StaticOrder S; S.init(NTOK, LDP, (int)gridDim.x, (int)blockIdx.x);
            pg8::EpiProj E{(bf16_t*)(P.ws + WS_PROJ)};
            pg8::gemm_phase(lds, gm, S, E);
        } else if (sub == 1) {
            a1_phase(P, layer, lds, tid);
            c1_phase(P, lds, tid);
        } else if (sub == 2) {
            phase_scan(P, tid);
            {
                unsigned* ctr = (unsigned*)(P.ws + WS_END) + 3584 + layer; LAS int* sit = (LAS int*)(lds + 132608);
                for (;;) {
                    if (tid == 0) *sit = (int)atomicAdd(ctr, 1u);
                    __syncthreads();
                    const int it = *sit;
                    __syncthreads();
                    if (it >= 640) break;
                    b_item(P, layer, lds, it, tid);
                }
            }
        } else if (sub == 3) {
            a3_phase(P, layer, lds, tid); __syncthreads();
            c3_phase(P, layer, lds, tid);
        } else if (sub == 4) {
            pg8::Gemm gm{(const bf16_t*)(P.ws + (layer == 0 ? WS_H : WS_D1)), (const bf16_t*)(P.ws + WS_WOUT) + (size_t)layer * DM * DM, NTOK, DM, DM};
            pg8::StaticOrder S; S.init(NTOK, DM, (int)gridDim.x, (int)blockIdx.x);
            pg8::EpiBf16 E{(bf16_t*)(P.ws + (layer == 0 ? WS_D1 : WS_PROJ)), DM};
            pg8::gemm_phase(lds, gm, S, E);
        } else {
            if (layer == 0) phase_norm<false>(P.x, (const bf16_t*)(P.ws + WS_D1), nullptr, P.norm_gain + DM, (bf16_t*)(P.ws + WS_H), nullptr, tid, (bf16_t*)(P.ws + WS_RR));
            else phase_final((const bf16_t*)(P.ws + WS_H), (const bf16_t*)(P.ws + WS_PROJ), (const float*)(P.ws + WS_RR), P.norm_gain + DM, P.final_gain, P.out, tid);
        }
        }
    }
}

constexpr int NPHASES = 13;
constexpr int LDS_BYTES = 131072 + 8192;

extern "C" void kernel_launch(void* const* d_in, const int* in_sizes, int n_in, void* d_out, int out_size, void* d_ws, size_t ws_size, hipStream_t stream) {
    static int grid = 0;
    if (grid == 0) {
        if (n_in != 8 || ws_size < WS_TOTAL) { fprintf(stderr, "kernel_launch: unexpected inputs (n_in %d, ws %zu < %zu)\n", n_in, ws_size, (size_t)WS_END); grid = -1; return; }
        if (hipFuncSetAttribute((const void*)hybrid_fwd, hipFuncAttributeMaxDynamicSharedMemorySize, LDS_BYTES) != hipSuccess) { fprintf(stderr, "hipFuncSetAttribute failed\n"); grid = -1; return; }
        int dev = 0, cus = 0, per_cu = 0;
        (void)hipGetDevice(&dev); (void)hipDeviceGetAttribute(&cus, hipDeviceAttributeMultiprocessorCount, dev);
        (void)hipOccupancyMaxActiveBlocksPerMultiprocessor(&per_cu, (const void*)hybrid_fwd, 512, LDS_BYTES);
        if (per_cu < 1) { fprintf(stderr, "occupancy query says 0 blocks per CU\n"); per_cu = 1; }
        (void)hipGetLastError();
        grid = cus;
    }
    if (grid < 0) return;
    Params p{};
    p.x = (const float*)d_in[0]; p.w_in = (const float*)d_in[1]; p.norm_gain = (const float*)d_in[2]; p.lb_logits = (const float*)d_in[3];
    p.hg_gain = (const float*)d_in[4]; p.rel_bias = (const float*)d_in[5]; p.w_out = (const float*)d_in[6]; p.final_gain = (const float*)d_in[7];
    p.out = (float*)d_out; p.ws = (unsigned char*)d_ws;
    if (hipMemsetAsync((unsigned char*)d_ws + WS_END, 0, WS_BARB, stream) != hipSuccess) { fprintf(stderr, "memset of the barrier words failed\n"); return; }
    p.ph_lo = 0; p.ph_hi = NPHASES;
    void* args[] = {&p};
    hipError_t e = hipLaunchCooperativeKernel((const void*)hybrid_fwd, dim3(grid), dim3(512), args, LDS_BYTES, stream);
    if (e != hipSuccess) fprintf(stderr, "cooperative launch failed: %s (grid %d)\n", hipGetErrorString(e), grid);
}
```
